# Optimizing an MI355X kernel written in HIP

```python
import math
import jax, jax.numpy as jnp
from jax import lax
import numpy as np

D_MODEL = 1024
BATCH = 8
SEQ = 2048
DEPTH = 1

HEAD_DIM = 64
FOX_HEADS = 8
FOX_WIDTH = FOX_HEADS * HEAD_DIM
MLSTM_HEADS = 8
MLSTM_QK_DIM = 32
MLSTM_V_DIM = 64
MLSTM_QK_WIDTH = MLSTM_HEADS * MLSTM_QK_DIM
MLSTM_V_WIDTH = MLSTM_HEADS * MLSTM_V_DIM
MIX_WIDTH = FOX_WIDTH + MLSTM_V_WIDTH
CONV_WIDTH = 4
FOX_BLOCK = 128
MLSTM_CHUNK = 64
SPLIT_WIDTHS = (FOX_WIDTH, FOX_WIDTH, FOX_WIDTH, FOX_HEADS,
                MLSTM_QK_WIDTH, MLSTM_QK_WIDTH, MLSTM_V_WIDTH,
                MLSTM_HEADS, MLSTM_HEADS, MLSTM_V_WIDTH)
IN_PROJ_WIDTH = sum(SPLIT_WIDTHS)
N_EXPERTS = 32
TOP_K = 4
D_EXPERT = D_MODEL
SWIGLU_ALPHA = 1.702
SWIGLU_LIMIT = 7.0
MOE_BLOCK = 128
NORM_EPS = 1e-5

kernel_name = "hymba_fox_mlstm_moe_layer"


def rms_norm(x, w):
    xf = x.astype(jnp.float32)
    y = xf * lax.rsqrt(jnp.mean(xf * xf, axis=-1, keepdims=True) + NORM_EPS)
    return (y * w.astype(jnp.float32)).astype(x.dtype)


def to_heads(t, n_heads):
    b, s, w = t.shape
    return t.reshape(b, s, n_heads, w // n_heads).transpose(0, 2, 1, 3)


def head_group_norm(t, w):
    b, h, s, d = t.shape
    tf = t.astype(jnp.float32)
    tf = tf * lax.rsqrt(jnp.mean(tf * tf, axis=-1, keepdims=True) + NORM_EPS)
    return tf.transpose(0, 2, 1, 3).reshape(b, s, h * d) * w.astype(jnp.float32)


def causal_depthwise_conv(u, w):
    c = u.shape[-1]
    return lax.conv_general_dilated(
        u, w.astype(u.dtype)[:, None, :], window_strides=(1,),
        padding=[(CONV_WIDTH - 1, 0)], dimension_numbers=('NWC', 'WIO', 'NWC'),
        feature_group_count=c)


def forgetting_attention(q, k, v, log_f):
    seq = q.shape[2]
    cum = jnp.cumsum(log_f, axis=-1)
    scale = 1.0 / math.sqrt(HEAD_DIM)
    outs = []
    for blk in range(seq // FOX_BLOCK):
        start, end = blk * FOX_BLOCK, (blk + 1) * FOX_BLOCK
        qb = q[:, :, start:end].astype(jnp.float32)
        kb = k[:, :, :end].astype(jnp.float32)
        vb = v[:, :, :end].astype(jnp.float32)
        scores = jnp.einsum('bhqd,bhkd->bhqk', qb, kb) * scale
        scores = scores + cum[:, :, start:end, None] - cum[:, :, None, :end]
        q_pos = start + jnp.arange(FOX_BLOCK)
        mask = jnp.arange(end)[None, :] <= q_pos[:, None]
        scores = jnp.where(mask, scores, -jnp.inf)
        probs = jax.nn.softmax(scores, axis=-1)
        outs.append(jnp.einsum('bhqk,bhkd->bhqd', probs, vb))
    return jnp.concatenate(outs, axis=2)


def mlstm_chunkwise(q, k, v, i_pre, log_f):
    b, h, seq, dk = q.shape
    dv = v.shape[-1]
    nc = seq // MLSTM_CHUNK
    k = k * (1.0 / math.sqrt(dk))

    def chunks(t):
        return jnp.moveaxis(t.reshape(t.shape[:2] + (nc, MLSTM_CHUNK) + t.shape[3:]), 2, 0)

    qs, ks, vs = (chunks(t.astype(jnp.float32)) for t in (q, k, v))
    is_, fs = chunks(i_pre), chunks(log_f)
    causal = jnp.tril(jnp.ones((MLSTM_CHUNK, MLSTM_CHUNK), dtype=bool))

    def step(carry, inp):
        c_s, n_s, m = carry
        qc, kc, vc, ic, fc = inp
        bcum = jnp.cumsum(fc, axis=-1)
        dmat = bcum[..., :, None] - bcum[..., None, :] + ic[..., None, :]
        dmat = jnp.where(causal, dmat, -jnp.inf)
        inter = bcum + m[..., None]
        m_t = jnp.maximum(inter, jnp.max(dmat, axis=-1))
        w_inter = jnp.exp(inter - m_t)
        s = jnp.einsum('bhtd,bhsd->bhts', qc, kc) * jnp.exp(dmat - m_t[..., None])
        num = (w_inter[..., None] * jnp.einsum('bhtd,bhde->bhte', qc, c_s)
               + jnp.einsum('bhts,bhse->bhte', s, vc))
        den = w_inter * jnp.einsum('bhtd,bhd->bht', qc, n_s) + jnp.sum(s, axis=-1)
        h_out = num / jnp.maximum(jnp.abs(den), jnp.exp(-m_t))[..., None]
        b_last = bcum[..., -1]
        g = b_last[..., None] - bcum + ic
        m_new = jnp.maximum(b_last + m, jnp.max(g, axis=-1))
        decay = jnp.exp(b_last + m - m_new)
        wk = jnp.exp(g - m_new[..., None])
        c_new = decay[..., None, None] * c_s + jnp.einsum('bhs,bhsd,bhse->bhde', wk, kc, vc)
        n_new = decay[..., None] * n_s + jnp.einsum('bhs,bhsd->bhd', wk, kc)
        return (c_new, n_new, m_new), h_out

    init = (jnp.zeros((b, h, dk, dv), jnp.float32), jnp.zeros((b, h, dk), jnp.float32),
            jnp.zeros((b, h), jnp.float32))
    _, hs = lax.scan(step, init, (qs, ks, vs, is_, fs))
    return jnp.moveaxis(hs, 0, 2).reshape(b, h, seq, dv)


def moe_ffn(h, router_w, router_b, w_gu, b_gu, w_down, b_down):
    bsz, seq, d = h.shape
    n_tok = bsz * seq
    hf = h.reshape(n_tok, d)
    logits = (hf @ router_w).astype(jnp.float32) + router_b.astype(jnp.float32)
    top_v, top_i = lax.top_k(logits, TOP_K)
    gates = jax.nn.softmax(top_v, axis=-1)

    n_slot = n_tok * TOP_K
    buf_len = -(-n_slot // MOE_BLOCK) * MOE_BLOCK + N_EXPERTS * MOE_BLOCK
    n_blocks = buf_len // MOE_BLOCK
    e_flat = top_i.reshape(-1)
    tok_flat = jnp.arange(n_slot, dtype=jnp.int32) // TOP_K
    order = jnp.argsort(e_flat)
    e_sorted, tok_sorted, w_sorted = e_flat[order], tok_flat[order], gates.reshape(-1)[order]
    counts = jnp.bincount(e_flat, length=N_EXPERTS)
    starts = jnp.cumsum(counts) - counts
    padded = ((counts + MOE_BLOCK - 1) // MOE_BLOCK) * MOE_BLOCK
    pad_end = jnp.cumsum(padded)
    pad_start = pad_end - padded
    pos = pad_start[e_sorted] + (jnp.arange(n_slot) - starts[e_sorted])
    buf_tok = jnp.zeros((buf_len,), jnp.int32).at[pos].set(tok_sorted)
    buf_w = jnp.zeros((buf_len,), jnp.float32).at[pos].set(w_sorted)
    block_e = jnp.minimum(
        jnp.searchsorted(pad_end, jnp.arange(n_blocks) * MOE_BLOCK, side='right'), N_EXPERTS - 1)

    def expert_block(args):
        idx, e = args
        xb = hf[idx]
        gu = xb @ w_gu[e] + b_gu[e]
        gate = jnp.minimum(gu[:, :D_EXPERT], SWIGLU_LIMIT)
        up = jnp.clip(gu[:, D_EXPERT:], -SWIGLU_LIMIT, SWIGLU_LIMIT)
        act = (up + 1.0) * (gate * jax.nn.sigmoid(SWIGLU_ALPHA * gate))
        return act @ w_down[e] + b_down[e]

    y = lax.map(expert_block, (buf_tok.reshape(n_blocks, MOE_BLOCK), block_e))
    y = y.reshape(buf_len, d).astype(jnp.float32) * buf_w[:, None]
    out = jnp.zeros((n_tok, d), jnp.float32).at[buf_tok].add(y)
    return out.reshape(bsz, seq, d).astype(h.dtype)


def setup_inputs(seed: int = 0) -> dict:
    key = jax.random.key(seed)
    ks = jax.random.split(key, 20)
    n = jax.random.normal
    L = DEPTH
    return {
        "x": n(ks[0], (BATCH, SEQ, D_MODEL), jnp.float32),
        "attn_norm_w": 1.0 + 0.02 * n(ks[1], (L, D_MODEL), jnp.float32),
        "w_in": n(ks[2], (L, D_MODEL, IN_PROJ_WIDTH), jnp.float32) * D_MODEL ** -0.5,
        "fox_f_bias": 3.0 + 0.5 * n(ks[3], (L, FOX_HEADS), jnp.float32),
        "fox_q_norm_w": 1.0 + 0.02 * n(ks[4], (L, HEAD_DIM), jnp.float32),
        "fox_k_norm_w": 1.0 + 0.02 * n(ks[5], (L, HEAD_DIM), jnp.float32),
        "fox_out_norm_w": 1.0 + 0.02 * n(ks[6], (L, FOX_WIDTH), jnp.float32),
        "mlstm_conv_w": 0.5 * n(ks[7], (L, CONV_WIDTH, 2 * MLSTM_QK_WIDTH), jnp.float32),
        "mlstm_i_bias": 0.1 * n(ks[8], (L, MLSTM_HEADS), jnp.float32),
        "mlstm_f_bias": 3.0 + 0.5 * n(ks[9], (L, MLSTM_HEADS), jnp.float32),
        "mlstm_out_norm_w": 1.0 + 0.02 * n(ks[10], (L, MLSTM_V_WIDTH), jnp.float32),
        "w_out": n(ks[11], (L, MIX_WIDTH, D_MODEL), jnp.float32) * MIX_WIDTH ** -0.5,
        "moe_norm_w": 1.0 + 0.02 * n(ks[12], (L, D_MODEL), jnp.float32),
        "router_w": n(ks[13], (L, D_MODEL, N_EXPERTS), jnp.float32) * D_MODEL ** -0.5,
        "router_b": 0.01 * n(ks[14], (L, N_EXPERTS), jnp.float32),
        "expert_w_gate_up": n(ks[15], (L, N_EXPERTS, D_MODEL, 2 * D_EXPERT), jnp.float32) * D_MODEL ** -0.5,
        "expert_b_gate_up": 0.01 * n(ks[16], (L, N_EXPERTS, 2 * D_EXPERT), jnp.float32),
        "expert_w_down": n(ks[17], (L, N_EXPERTS, D_EXPERT, D_MODEL), jnp.float32) * D_EXPERT ** -0.5,
        "expert_b_down": 0.01 * n(ks[18], (L, N_EXPERTS, D_MODEL), jnp.float32),
    }


def reference(x, attn_norm_w, w_in, fox_f_bias, fox_q_norm_w, fox_k_norm_w, fox_out_norm_w,
              mlstm_conv_w, mlstm_i_bias, mlstm_f_bias, mlstm_out_norm_w, w_out, moe_norm_w,
              router_w, router_b, expert_w_gate_up, expert_b_gate_up, expert_w_down,
              expert_b_down):
    split_at = [int(s) for s in np.cumsum(SPLIT_WIDTHS)[:-1]]
    for layer in range(DEPTH):
        h = rms_norm(x, attn_norm_w[layer])
        proj = h @ w_in[layer]
        (fq, fk, fv, ff, mq, mk, mv, mi, mf, mo) = jnp.split(proj, split_at, axis=-1)

        fq = rms_norm(to_heads(fq, FOX_HEADS), fox_q_norm_w[layer])
        fk = rms_norm(to_heads(fk, FOX_HEADS), fox_k_norm_w[layer])
        fv = to_heads(fv, FOX_HEADS)
        fox_log_f = jax.nn.log_sigmoid(
            (ff + fox_f_bias[layer]).astype(jnp.float32)).transpose(0, 2, 1)
        fox_y = head_group_norm(forgetting_attention(fq, fk, fv, fox_log_f),
                                fox_out_norm_w[layer])

        qk = jax.nn.silu(causal_depthwise_conv(jnp.concatenate([mq, mk], axis=-1),
                                               mlstm_conv_w[layer]))
        mq, mk = qk[..., :MLSTM_QK_WIDTH], qk[..., MLSTM_QK_WIDTH:]
        m_i = (mi + mlstm_i_bias[layer]).astype(jnp.float32).transpose(0, 2, 1)
        m_log_f = jax.nn.log_sigmoid(
            (mf + mlstm_f_bias[layer]).astype(jnp.float32)).transpose(0, 2, 1)
        m_h = mlstm_chunkwise(to_heads(mq, MLSTM_HEADS), to_heads(mk, MLSTM_HEADS),
                              to_heads(mv, MLSTM_HEADS), m_i, m_log_f)
        mlstm_y = head_group_norm(m_h, mlstm_out_norm_w[layer]) * jax.nn.sigmoid(
            mo.astype(jnp.float32))

        mixed = jnp.concatenate([fox_y, mlstm_y], axis=-1).astype(x.dtype)
        x = x + mixed @ w_out[layer]

        h2 = rms_norm(x, moe_norm_w[layer])
        x = x + moe_ffn(h2, router_w[layer], router_b[layer], expert_w_gate_up[layer],
                        expert_b_gate_up[layer], expert_w_down[layer], expert_b_down[layer])
    return x
```

```cpp
#define MK_N_LAUNCHES 10
#include <hip/hip_runtime.h>
#include <hip/hip_bf16.h>
#include <cstdio>
#include <cstdint>
#include <cmath>

constexpr int BATCH = 8, SEQ = 2048, DMODEL = 1024, MTOK = BATCH * SEQ;
constexpr int FH = 8, HD = 64, MH = 8, MQKD = 32, MVD = 64;
constexpr int INW = 3096;
constexpr int NE = 32, TOPK = 4, DE = 1024;
constexpr int NSLOT = MTOK * TOPK;
constexpr int MAXPOS = NSLOT + NE * 256;
constexpr float NORM_EPS = 1e-5f;
constexpr float LOG2E = 1.4426950408889634f;
constexpr float QSCALE = 0.125f * LOG2E;

namespace pg8 {
#define PG8_LAS __attribute__((address_space(3)))
typedef unsigned short bf16_t;
typedef short bf16x8 __attribute__((ext_vector_type(8)));
typedef float f32x4 __attribute__((ext_vector_type(4)));
typedef unsigned u32x4 __attribute__((ext_vector_type(4)));
constexpr int BM = 256, BK = 64, HALF = 128, HTB = HALF * BK * 2  , STAGE_BYTES = 8 * HTB, NXCD = 8, WGM = 8;

__host__ __device__ __forceinline__ int lds_byte(int r, int c) { const int st = (r >> 4) * 2 + (c >> 5), rr = r & 15, cc = c & 31, ob = rr * 64 + cc * 2; return st * 1024 + (ob ^ (((ob >> 9) & 1) << 5)); }
__host__ __device__ __forceinline__ void stage_rc(int b, int& R, int& C) { const int st = b / 1024, sb = b % 1024, swz = sb ^ (((sb >> 9) & 1) << 5); R = (st >> 1) * 16 + swz / 64; C = (st & 1) * 32 + (swz % 64) / 2; }
__host__ __device__ __forceinline__ int perm32(int rho) { const int n = rho >> 4, i = rho & 15; return 8 * (i >> 2) + 4 * n + (i & 3); }

struct Unit { int pm, pn; };
struct Gemm { const bf16_t* A; const bf16_t* Bt; int K; const int* rowidx; };

struct StaticOrder {
    int nM, nN, nwg, G, c;
    __host__ __device__ void init(int M, int N, int G_, int c_) { nM = M / BM; nN = N / BM; nwg = nM * nN; G = G_; c = c_; }
    __host__ __device__ bool next(int i, Unit& u) const {
        const long L = (long)i * G + c; if (L >= nwg) return false;
        int wgid = (int)L; { const int q = nwg / NXCD, r = nwg % NXCD, xcd = wgid % NXCD, off = wgid / NXCD; wgid = (xcd < r ? xcd * (q + 1) : r * (q + 1) + (xcd - r) * q) + off; }
        const int nig = WGM * nN, gid = wgid / nig, fm = gid * WGM, gsz = (nM - fm) < WGM ? (nM - fm) : WGM;
        u.pm = fm + ((wgid % nig) % gsz); u.pn = (wgid % nig) / gsz; return true;
    }
};
struct MoeOrder {
    const int* tp; int npn, G, cc, total;
    __device__ void init(const int* tp_, int npn_, int G_, int c_) { tp = tp_; npn = npn_; G = G_; cc = (G_ % 8 == 0) ? (c_ % 8) * (G_ / 8) + c_ / 8 : c_; total = tp_[NE] * npn_; }
    __device__ bool next(int i, Unit& u) const {
        const int U = i * G + cc; if (U >= total) return false;
        int e = 0;
        while (e < NE - 1 && U >= tp[e + 1] * npn) ++e;
        const int w = U - tp[e] * npn, mte = tp[e + 1] - tp[e];
        u.pm = tp[e] + (w % mte); u.pn = e * npn + (w / mte); return true;
    }
};

__device__ __forceinline__ unsigned cvt_pk_bf16(float lo, float hi) { unsigned r; asm volatile("v_cvt_pk_bf16_f32 %0, %1, %2" : "=v"(r) : "v"(lo), "v"(hi)); return r; }

struct EpiInProj {
    static constexpr bool PERM = true;
    bf16_t* base; size_t tstride; const float* wq; const float* wk;
    __device__ __forceinline__ void operator()(const f32x4 (&acc)[2][2][4][2], const Unit& u, int wr, int wc, int fr, int fq) const {
        const int tt = u.pn >> 1, row0 = u.pm * BM + wr * 64 + fr, colb = (u.pn & 1) * 256 + 64 * wc + 8 * fq;
        bf16_t* T = base + (size_t)tt * tstride;
        if (tt <= 1) {
            const float* w = tt == 0 ? wq : wk; const float sc = tt == 0 ? QSCALE : 1.0f;
            f32x4 wv[2][2];
#pragma unroll
            for (int bj = 0; bj < 2; ++bj)
#pragma unroll
                for (int n = 0; n < 2; ++n) wv[bj][n] = *(const f32x4*)(w + 32 * bj + 8 * fq + 4 * n) * sc;
#pragma unroll
            for (int ai = 0; ai < 2; ++ai)
#pragma unroll
                for (int m = 0; m < 4; ++m) {
                    float ss = 0.f;
#pragma unroll
                    for (int bj = 0; bj < 2; ++bj)
#pragma unroll
                        for (int n = 0; n < 2; ++n) { const f32x4 x = acc[ai][bj][m][n]; ss += (x[0] * x[0] + x[1] * x[1]) + (x[2] * x[2] + x[3] * x[3]); }
                    ss += __shfl_xor(ss, 16); ss += __shfl_xor(ss, 32);
                    const float rstd = 1.0f / sqrtf(ss * (1.0f / 64.0f) + NORM_EPS);
                    bf16_t* rowp = T + (size_t)(row0 + ai * HALF + m * 16) * 512 + colb;
#pragma unroll
                    for (int bj = 0; bj < 2; ++bj) { const f32x4 v0 = acc[ai][bj][m][0] * rstd * wv[bj][0], v1 = acc[ai][bj][m][1] * rstd * wv[bj][1];
                        u32x4 o; o.x = cvt_pk_bf16(v0[0], v0[1]); o.y = cvt_pk_bf16(v0[2], v0[3]); o.z = cvt_pk_bf16(v1[0], v1[1]); o.w = cvt_pk_bf16(v1[2], v1[3]);
                        *(u32x4*)(rowp + 32 * bj) = o; }
                }
        } else {
#pragma unroll
            for (int ai = 0; ai < 2; ++ai)
#pragma unroll
                for (int m = 0; m < 4; ++m) { bf16_t* rowp = T + (size_t)(row0 + ai * HALF + m * 16) * 512 + colb;
#pragma unroll
                    for (int bj = 0; bj < 2; ++bj) { const f32x4 v0 = acc[ai][bj][m][0], v1 = acc[ai][bj][m][1];
                        u32x4 o; o.x = cvt_pk_bf16(v0[0], v0[1]); o.y = cvt_pk_bf16(v0[2], v0[3]); o.z = cvt_pk_bf16(v1[0], v1[1]); o.w = cvt_pk_bf16(v1[2], v1[3]);
                        *(u32x4*)(rowp + 32 * bj) = o; } }
        }
    }
};
struct EpiResid {
    static constexpr bool PERM = false;
    const float* resid; float* out; int ldc;
    __device__ __forceinline__ void operator()(const f32x4 (&acc)[2][2][4][2], const Unit& u, int wr, int wc, int fr, int fq) const {
        const int row0 = u.pm * BM + wr * 64 + fr, col0 = u.pn * BM + wc * 32 + 4 * fq;
#pragma unroll
        for (int ai = 0; ai < 2; ++ai)
#pragma unroll
            for (int m = 0; m < 4; ++m) { const size_t off = (size_t)(row0 + ai * HALF + m * 16) * ldc + col0;
#pragma unroll
                for (int bj = 0; bj < 2; ++bj)
#pragma unroll
                    for (int n = 0; n < 2; ++n) *(f32x4*)(out + off + bj * HALF + n * 16) = *(const f32x4*)(resid + off + bj * HALF + n * 16) + acc[ai][bj][m][n]; }
    }
};
struct EpiSwiGLU {
    static constexpr bool PERM = true;
    bf16_t* act; const float* bgu;
    __device__ __forceinline__ void operator()(const f32x4 (&acc)[2][2][4][2], const Unit& u, int wr, int wc, int fr, int fq) const {
        const int e = u.pn >> 3, pnl = u.pn & 7, row0 = u.pm * BM + wr * 64 + fr, colg = 128 * pnl + 32 * wc + 8 * fq;
        f32x4 bg[2], bu[2];
#pragma unroll
        for (int n = 0; n < 2; ++n) { bg[n] = *(const f32x4*)(bgu + (size_t)e * 2048 + colg + 4 * n); bu[n] = *(const f32x4*)(bgu + (size_t)e * 2048 + 1024 + colg + 4 * n); }
#pragma unroll
        for (int ai = 0; ai < 2; ++ai)
#pragma unroll
            for (int m = 0; m < 4; ++m) {
                unsigned w[4];
#pragma unroll
                for (int n = 0; n < 2; ++n) { const f32x4 g4 = acc[ai][0][m][n] + bg[n], u4 = acc[ai][1][m][n] + bu[n]; float r[4];
#pragma unroll
                    for (int i = 0; i < 4; ++i) { const float g = fminf(g4[i], 7.0f), uu = fminf(fmaxf(u4[i], -7.0f), 7.0f);
                        const float sg = __builtin_amdgcn_rcpf(1.0f + __builtin_amdgcn_exp2f(-1.702f * LOG2E * g)); r[i] = (uu + 1.0f) * (g * sg); }
                    w[2 * n] = cvt_pk_bf16(r[0], r[1]); w[2 * n + 1] = cvt_pk_bf16(r[2], r[3]); }
                u32x4 o; o.x = w[0]; o.y = w[1]; o.z = w[2]; o.w = w[3];
                *(u32x4*)(act + (size_t)(row0 + ai * HALF + m * 16) * DE + colg) = o;
            }
    }
};
struct EpiDown {
    static constexpr bool PERM = true;
    bf16_t* y; const float* bd; const float* gate;
    __device__ __forceinline__ void operator()(const f32x4 (&acc)[2][2][4][2], const Unit& u, int wr, int wc, int fr, int fq) const {
        const int e = u.pn >> 2, pnl = u.pn & 3, row0 = u.pm * BM + wr * 64 + fr, col0 = 256 * pnl + 32 * wc + 8 * fq;
        f32x4 bv[2][2];
#pragma unroll
        for (int bj = 0; bj < 2; ++bj)
#pragma unroll
            for (int n = 0; n < 2; ++n) bv[bj][n] = *(const f32x4*)(bd + (size_t)e * DMODEL + col0 + bj * HALF + 4 * n);
#pragma unroll
        for (int ai = 0; ai < 2; ++ai)
#pragma unroll
            for (int m = 0; m < 4; ++m) { const int row = row0 + ai * HALF + m * 16; const float gw = gate[row]; bf16_t* rowp = y + (size_t)row * DMODEL + col0;
#pragma unroll
                for (int bj = 0; bj < 2; ++bj) { const f32x4 v0 = (acc[ai][bj][m][0] + bv[bj][0]) * gw, v1 = (acc[ai][bj][m][1] + bv[bj][1]) * gw;
                    u32x4 o; o.x = cvt_pk_bf16(v0[0], v0[1]); o.y = cvt_pk_bf16(v0[2], v0[3]); o.z = cvt_pk_bf16(v1[0], v1[1]); o.w = cvt_pk_bf16(v1[2], v1[3]);
                    *(u32x4*)(rowp + bj * HALF) = o; } }
    }
};

template <class Epi, class Sched, bool ALIGN_EPI, bool GATHER>
__device__ __forceinline__ void gemm_phase(PG8_LAS unsigned char* lds, const Gemm g, const Sched& S, const Epi& E) {
    const int tid = threadIdx.x, wid = __builtin_amdgcn_readfirstlane(tid >> 6), lane = tid & 63, wr = wid >> 2, wc = wid & 3, fr = lane & 15, fq = lane >> 4;
    const int K = g.K, nt = K / BK;
    unsigned voffA[2], voffB[2]; int RA[2], CA[2];
#pragma unroll
    for (int i = 0; i < 2; ++i) { int R, C; stage_rc(tid * 16 + i * 8192, R, C); const int Rb = Epi::PERM ? ((R & ~31) + perm32(R & 31)) : R;
        RA[i] = R; CA[i] = C; voffA[i] = (unsigned)(R * K + C) * 2u; voffB[i] = (unsigned)(Rb * K + C) * 2u; }
    const size_t kstep = (size_t)(BK * 2);
    const size_t hstep = (size_t)HALF * K * 2;
    const size_t tstep = 2 * hstep;
    const unsigned ldsw = (unsigned)wid * 1024u;
    const int aoff = lds_byte(wr * 64 + fr, fq * 8), boff = lds_byte(wc * 32 + fr, fq * 8);
#define PG8_SA(b, h) (((b) * 2 + (h)) * HTB)
#define PG8_SB(b, h) ((4 + (b) * 2 + (h)) * HTB)
#define PG8_STAGE(bufoff, gbase, voff) do { _Pragma("unroll") for (int _i = 0; _i < 2; ++_i) \
        __builtin_amdgcn_global_load_lds((const unsigned*)((const char*)(gbase) + (voff)[_i]), (PG8_LAS unsigned*)(lds + (bufoff) + ldsw + _i * 8192), 16, 0, 0); } while (0)
#define PG8_STAGE_A(bufoff, p, h, vg) do { if constexpr (GATHER) { PG8_STAGE(bufoff, p, (vg)[h]); } else { PG8_STAGE(bufoff, (p) + (h) * hstep, voffA); } } while (0)
#define PG8_LDA(dst, b, h) do { _Pragma("unroll") for (int m = 0; m < 4; ++m) _Pragma("unroll") for (int k = 0; k < 2; ++k) dst[m][k] = *(const PG8_LAS bf16x8*)(lds + PG8_SA(b, h) + aoff + m * 2048 + k * 1024); } while (0)
#define PG8_LDB(dst, b, h) do { _Pragma("unroll") for (int n = 0; n < 2; ++n) _Pragma("unroll") for (int k = 0; k < 2; ++k) dst[n][k] = *(const PG8_LAS bf16x8*)(lds + PG8_SB(b, h) + boff + n * 2048 + k * 1024); } while (0)
#define PG8_MMA(ai, bj, At, Bt) do { __builtin_amdgcn_s_setprio(1); _Pragma("unroll") for (int m = 0; m < 4; ++m) _Pragma("unroll") for (int n = 0; n < 2; ++n) _Pragma("unroll") for (int k = 0; k < 2; ++k) \
        acc[ai][bj][m][n] = __builtin_amdgcn_mfma_f32_16x16x32_bf16(Bt[n][k], At[m][k], acc[ai][bj][m][n], 0, 0, 0); __builtin_amdgcn_s_setprio(0); } while (0)
#define PG8_WAIT_V(n) asm volatile("s_waitcnt vmcnt(" #n ")" ::: "memory")
#define PG8_WAIT_L(n) asm volatile("s_waitcnt lgkmcnt(" #n ")" ::: "memory")
#define PG8_BAR __builtin_amdgcn_s_barrier()
#define PG8_SCHED __builtin_amdgcn_sched_barrier(0)
    Unit cur, nxt; int ui = 0;
    if (!S.next(0, cur)) return;
    f32x4 acc[2][2][4][2];
#pragma unroll
    for (int a = 0; a < 2; ++a)
#pragma unroll
        for (int b = 0; b < 2; ++b)
#pragma unroll
            for (int m = 0; m < 4; ++m)
#pragma unroll
                for (int n = 0; n < 2; ++n) acc[a][b][m][n] = (f32x4){0.f, 0.f, 0.f, 0.f};
    bf16x8 At[4][2], B0[2][2], B1[2][2];
    unsigned vgC[2][2], vgN[2][2];
    if constexpr (GATHER) {
#pragma unroll
        for (int h = 0; h < 2; ++h)
#pragma unroll
            for (int i = 0; i < 2; ++i) { vgC[h][i] = ((unsigned)g.rowidx[cur.pm * BM + h * HALF + RA[i]] * (unsigned)K + (unsigned)CA[i]) * 2u; vgN[h][i] = vgC[h][i]; }
    }
    const char* cA = GATHER ? (const char*)g.A : (const char*)g.A + (size_t)cur.pm * tstep; const char* cB = (const char*)g.Bt + (size_t)cur.pn * tstep;
    PG8_STAGE(PG8_SB(0, 0), cB, voffB); PG8_STAGE(PG8_SB(0, 1), cB + hstep, voffB); PG8_STAGE_A(PG8_SA(0, 0), cA, 0, vgC); PG8_STAGE_A(PG8_SA(0, 1), cA, 1, vgC);
    if (wr == 1) PG8_BAR;
    PG8_WAIT_V(2); PG8_BAR;
    PG8_STAGE(PG8_SB(1, 0), cB + kstep, voffB); PG8_STAGE_A(PG8_SA(1, 0), cA + kstep, 0, vgC); PG8_STAGE(PG8_SB(1, 1), cB + hstep + kstep, voffB);
    PG8_WAIT_V(6); PG8_BAR;
    for (;;) {
        const bool has_next = S.next(ui + 1, nxt);
        if constexpr (GATHER) { if (has_next) {
#pragma unroll
            for (int h = 0; h < 2; ++h)
#pragma unroll
                for (int i = 0; i < 2; ++i) vgN[h][i] = ((unsigned)g.rowidx[nxt.pm * BM + h * HALF + RA[i]] * (unsigned)K + (unsigned)CA[i]) * 2u; } }
        const char* nA = GATHER ? cA : (has_next ? (const char*)g.A + (size_t)nxt.pm * tstep : cA); const char* nB = has_next ? (const char*)g.Bt + (size_t)nxt.pn * tstep : cB;
        for (int t = 0; t < nt; t += 2) {
            const bool last = (t == nt - 2);
            const char* a1 = cA + (size_t)(t + 1) * kstep;
            const char* a2 = last ? nA : cA + (size_t)(t + 2) * kstep; const char* b2 = last ? nB : cB + (size_t)(t + 2) * kstep;
            const char* a3 = a2 + kstep; const char* b3 = b2 + kstep;
            unsigned vg2[2][2];
            if constexpr (GATHER) {
#pragma unroll
                for (int h = 0; h < 2; ++h)
#pragma unroll
                    for (int i = 0; i < 2; ++i) vg2[h][i] = last ? vgN[h][i] : vgC[h][i];
            }
            PG8_LDB(B0, 0, 0); PG8_LDB(B1, 0, 1); PG8_SCHED; PG8_LDA(At, 0, 0); PG8_STAGE_A(PG8_SA(1, 1), a1, 1, vgC);
            PG8_WAIT_V(8); PG8_WAIT_L(0); PG8_BAR; PG8_MMA(0, 0, At, B0); PG8_MMA(0, 1, At, B1); PG8_BAR; PG8_SCHED;
            PG8_LDA(At, 0, 1); PG8_STAGE(PG8_SB(0, 0), b2, voffB); PG8_STAGE(PG8_SB(0, 1), b2 + hstep, voffB); PG8_STAGE_A(PG8_SA(0, 0), a2, 0, vg2);
            PG8_WAIT_V(8); PG8_WAIT_L(0); PG8_BAR; PG8_MMA(1, 0, At, B0); PG8_MMA(1, 1, At, B1); PG8_BAR; PG8_SCHED;
            PG8_LDB(B0, 1, 0); PG8_LDB(B1, 1, 1); PG8_SCHED; PG8_LDA(At, 1, 0); PG8_STAGE_A(PG8_SA(0, 1), a2, 1, vg2);
            PG8_WAIT_V(8); PG8_WAIT_L(0); PG8_BAR; PG8_MMA(0, 0, At, B0); PG8_MMA(0, 1, At, B1); PG8_BAR; PG8_SCHED;
            PG8_LDA(At, 1, 1); PG8_STAGE(PG8_SB(1, 0), b3, voffB); PG8_STAGE(PG8_SB(1, 1), b3 + hstep, voffB); PG8_STAGE_A(PG8_SA(1, 0), a3, 0, vg2);
            PG8_WAIT_V(8); PG8_WAIT_L(0); PG8_BAR; PG8_MMA(1, 0, At, B0); PG8_MMA(1, 1, At, B1); PG8_BAR; PG8_SCHED;
        }
        if constexpr (ALIGN_EPI) { if (wr == 0) PG8_BAR; }
        E(acc, cur, wr, wc, fr, fq);
        if (!has_next) break;
#pragma unroll
        for (int a = 0; a < 2; ++a)
#pragma unroll
            for (int b = 0; b < 2; ++b)
#pragma unroll
                for (int m = 0; m < 4; ++m)
#pragma unroll
                    for (int n = 0; n < 2; ++n) acc[a][b][m][n] = (f32x4){0.f, 0.f, 0.f, 0.f};
        cur = nxt; cA = nA; cB = nB; ++ui;
        if constexpr (GATHER) {
#pragma unroll
            for (int h = 0; h < 2; ++h)
#pragma unroll
                for (int i = 0; i < 2; ++i) vgC[h][i] = vgN[h][i];
        }
        if constexpr (ALIGN_EPI) { if (wr == 1) PG8_BAR; }
    }
    PG8_WAIT_V(0);
    if constexpr (!ALIGN_EPI) { if (wr == 0) PG8_BAR; }
    PG8_BAR;
#undef PG8_SA
#undef PG8_SB
#undef PG8_STAGE
#undef PG8_STAGE_A
#undef PG8_LDA
#undef PG8_LDB
#undef PG8_MMA
#undef PG8_WAIT_V
#undef PG8_WAIT_L
#undef PG8_BAR
#undef PG8_SCHED
}
}
namespace attn_body {
using bf16=__hip_bfloat16;
using bf16x8=__attribute__((ext_vector_type(8)))short;
using s16x4=__attribute__((ext_vector_type(4)))short;
using f32x16=__attribute__((ext_vector_type(16)))float;
using u32x4=__attribute__((ext_vector_type(4)))unsigned;
typedef float f32x4_t __attribute__((ext_vector_type(4)));
constexpr int BATCH=8,NHEAD=8,SEQ=2048,D=64,DM=NHEAD*D,OPITCH=1024;
constexpr int NW=8,QBLK=32,QB=QBLK*NW,KVBLK=64,NQB=SEQ/QB;
static_assert(NQB==8,"static order assumes 8 query blocks per (b,h)");
__device__ __forceinline__ int crow(int r,int hi){return (r&3)+8*(r>>2)+4*hi;}
#define SBAR() __builtin_amdgcn_sched_barrier(0)
__device__ __forceinline__ void cmask(f32x16&p0,f32x16&p1,int jb,int qrel,int hi){
  const float NEG=-INFINITY; int kb=64*jb+4*hi;
  #pragma unroll
  for(int r=0;r<16;++r){int kv=kb+(r&3)+8*(r>>2); if(kv>qrel)p0[r]=NEG; if(kv+32>qrel)p1[r]=NEG;}
}

constexpr int NSLOT=3, SLOTB=8192;
constexpr int LDS_K=0, LDS_V=NSLOT*SLOTB, LDS_WS=2*NSLOT*SLOTB, LDS_OST=LDS_WS+NW*64*4, LDS_KB=LDS_OST+NW*4096, LDS_BYTES=LDS_KB+SEQ*4;
constexpr float C2=0.125f*1.4426950408889634f;
__device__ __forceinline__ void glds16(const void*gsrc,unsigned lds_dst){unsigned keep;
  asm volatile("s_mov_b32 %0, m0\n\ts_mov_b32 m0, %2\n\ts_nop 0\n\tglobal_load_lds_dwordx4 %1, off\n\ts_mov_b32 m0, %0":"=&s"(keep):"v"(gsrc),"s"(lds_dst):"memory");}
__device__ __forceinline__ float max3f(float a,float b,float c){float r;asm("v_max3_f32 %0, %1, %2, %3":"=v"(r):"v"(a),"v"(b),"v"(c));return r;}
__device__ __forceinline__ float max2f(float a,float b){float r;asm("v_max_f32_e32 %0, %1, %2":"=v"(r):"v"(a),"v"(b));return r;}
__device__ __forceinline__ float fadd_s(float a,float b){float r;asm("v_add_f32_e32 %0, %1, %2":"=v"(r):"v"(a),"v"(b));return r;}
__device__ __forceinline__ float fsub_s(float a,float b){float r;asm("v_sub_f32_e32 %0, %1, %2":"=v"(r):"v"(a),"v"(b));return r;}
typedef float f32x2_t __attribute__((ext_vector_type(2))); typedef __bf16 bf16x2_t __attribute__((ext_vector_type(2)));
__device__ __forceinline__ unsigned cvtpk_s(float lo,float hi){f32x2_t v={lo,hi};bf16x2_t b=__builtin_convertvector(v,bf16x2_t);return __builtin_bit_cast(unsigned,b);}
#define WAIT_BAR(N) asm volatile("s_waitcnt vmcnt(" #N ") lgkmcnt(0)\n\ts_barrier":::"memory")

__device__ __forceinline__ void qkt(f32x16&p0,f32x16&p1,const char*Kslot,const bf16x8*qr,int r32,int hi){
  const char*kb=Kslot+hi*1024+r32*16;
  #pragma unroll
  for(int d0=0;d0<4;++d0){
    const bf16x8 b0=*reinterpret_cast<const bf16x8*>(kb+d0*2048);
    const bf16x8 b1=*reinterpret_cast<const bf16x8*>(kb+d0*2048+512);
    {p0=__builtin_amdgcn_mfma_f32_32x32x16_bf16(b0,qr[d0],p0,0,0,0);p1=__builtin_amdgcn_mfma_f32_32x32x16_bf16(b1,qr[d0],p1,0,0,0);}}
}
typedef __attribute__((address_space(3))) const char* lds_cptr;
typedef short v4i16_t __attribute__((ext_vector_type(4)));
__device__ __forceinline__ void kload8(bf16x8*kf,lds_cptr kp){
  kf[0]=*(const __attribute__((address_space(3))) bf16x8*)(kp);      kf[1]=*(const __attribute__((address_space(3))) bf16x8*)(kp+512);
  kf[2]=*(const __attribute__((address_space(3))) bf16x8*)(kp+2048); kf[3]=*(const __attribute__((address_space(3))) bf16x8*)(kp+2560);
  kf[4]=*(const __attribute__((address_space(3))) bf16x8*)(kp+4096); kf[5]=*(const __attribute__((address_space(3))) bf16x8*)(kp+4608);
  kf[6]=*(const __attribute__((address_space(3))) bf16x8*)(kp+6144); kf[7]=*(const __attribute__((address_space(3))) bf16x8*)(kp+6656);
}
__device__ __forceinline__ void kload2(bf16x8*kf,lds_cptr kp,int j){ kf[2*j]=*(const __attribute__((address_space(3))) bf16x8*)(kp+j*2048); kf[2*j+1]=*(const __attribute__((address_space(3))) bf16x8*)(kp+j*2048+512); }
__device__ __forceinline__ s16x4 vtr(lds_cptr p){ return __builtin_bit_cast(s16x4,__builtin_amdgcn_ds_read_tr16_b64_v4i16((__attribute__((address_space(3))) v4i16_t*)p)); }
__device__ __forceinline__ float rowmax(const f32x16&p0,const f32x16&p1){
  float a=max3f(p0[0],p0[1],p1[0]),b=max3f(p0[2],p0[3],p1[1]);a=max3f(a,p1[2],p1[3]);
  #pragma unroll
  for(int r=4;r<16;r+=4){a=max3f(a,p0[r],p0[r+1]);b=max3f(b,p0[r+2],p0[r+3]);a=max3f(a,p1[r],p1[r+1]);b=max3f(b,p1[r+2],p1[r+3]);}
  const float m=max2f(a,b);
  auto rr=__builtin_amdgcn_permlane32_swap(__float_as_uint(m),__float_as_uint(m),false,false);
  return max2f(__uint_as_float(rr[0]),__uint_as_float(rr[1]));
}
__device__ __forceinline__ void pv(f32x16*o,int vb,bf16x8 pa0,bf16x8 pa1,bf16x8 pa2,bf16x8 pa3){
  #pragma unroll
  for(int d0=0;d0<2;++d0){s16x4 lo[4],hi[4];
    #pragma unroll
    for(int ks=0;ks<4;++ks){
      asm volatile("ds_read_b64_tr_b16 %0,%1 offset:%c2":"=&v"(lo[ks]):"v"(vb),"i"(d0*4096+ks*1024):"memory");
      asm volatile("ds_read_b64_tr_b16 %0,%1 offset:%c2":"=&v"(hi[ks]):"v"(vb),"i"(d0*4096+ks*1024+512):"memory");}
    asm volatile("s_waitcnt lgkmcnt(0)":::"memory");SBAR();
    #define PK(k) (bf16x8){lo[k][0],lo[k][1],lo[k][2],lo[k][3],hi[k][0],hi[k][1],hi[k][2],hi[k][3]}
    o[d0]=__builtin_amdgcn_mfma_f32_32x32x16_bf16(pa0,PK(0),o[d0],0,0,0);
    o[d0]=__builtin_amdgcn_mfma_f32_32x32x16_bf16(pa1,PK(1),o[d0],0,0,0);
    o[d0]=__builtin_amdgcn_mfma_f32_32x32x16_bf16(pa2,PK(2),o[d0],0,0,0);
    o[d0]=__builtin_amdgcn_mfma_f32_32x32x16_bf16(pa3,PK(3),o[d0],0,0,0);
    #undef PK
  }
}

#ifndef ATTN_STORE16
#define ATTN_STORE16(p,v) (*(u32x4*)(p)=(v))
#endif
template<int THRL> __device__ __forceinline__ void attn_unit(int b,int h,int qb,const bf16*Q,const bf16*__restrict__ K,const bf16*__restrict__ V,bf16*O,const float*kbias,const float*onw,char*shm){
  const int tid=threadIdx.x,lane=tid&63,r32=lane&31,hi=lane>>5; const int wid=__builtin_amdgcn_readfirstlane(tid>>6);
  const long rowbase=(long)b*SEQ; const int q0=qb*QB;
  const bf16*Qw=Q+(rowbase+q0+wid*QBLK)*DM+h*D;
  const bf16*Kh=K+rowbase*DM+h*D,*Vh=V+rowbase*DM+h*D;
  const unsigned lds0=(unsigned)(uintptr_t)shm;
  float*wsf=(float*)(shm+LDS_WS)+wid*64;
  const bf16*ksrc=Kh+(long)lane*DM+wid*8;
  const bf16*vsrc=Vh+(long)(16*(wid&3)+(lane>>2))*DM+(wid>>2)*32+(lane&3)*8;
  const unsigned kdst=lds0+LDS_K+wid*1024, vdst=lds0+LDS_V+wid*1024;
  #define DMA_K(t,slot) glds16(ksrc+(long)(t)*KVBLK*DM,(unsigned)__builtin_amdgcn_readfirstlane(kdst+(slot)))
  #define DMA_V(t,slot) glds16(vsrc+(long)(t)*KVBLK*DM,(unsigned)__builtin_amdgcn_readfirstlane(vdst+(slot)))
  const int vb0=(int)(lds0+LDS_V)+((lane>>4)&1)*32+(lane&3)*8+(4*hi+((lane&15)>>2))*64;
  const char*Kbase=shm+LDS_K; bf16x8 kf[8];
  const lds_cptr shm3=(lds_cptr)shm; const lds_cptr kp0=shm3+LDS_K+hi*1024+r32*16; const lds_cptr vp0=shm3+LDS_V+((lane>>4)&1)*32+(lane&3)*8+(4*hi+((lane&15)>>2))*64;
  const int NT=(q0+QB)/KVBLK;
  { const float*kbg=kbias+(long)(b*NHEAD+h)*SEQ;
    if(tid*4<NT*KVBLK){ const f32x4_t kv4=*(const f32x4_t*)(kbg+tid*4); *(__attribute__((address_space(3))) f32x4_t*)(shm3+LDS_KB+tid*16)=kv4; } }
  DMA_K(0,0);DMA_V(0,0);DMA_K(1,SLOTB);
  bf16x8 qr[4];
  #pragma unroll
  for(int d0=0;d0<4;++d0)qr[d0]=*reinterpret_cast<const bf16x8*>(&Qw[(long)r32*DM+d0*16+hi*8]);
  float mhat=0.f,l_reg=0.f;f32x16 o[2];o[0]=f32x16{};o[1]=f32x16{};
  const int qrel=wid*QBLK+r32;
  #define CMASK(P0,P1,t) do{int jb_=(t)-(NT-4); if(jb_>=0)cmask(P0,P1,jb_,qrel,hi);}while(0)
  #define KBIAS(P0,P1,t) do{ const lds_cptr kb_=shm3+LDS_KB+(t)*256+hi*16; _Pragma("unroll") for(int g_=0;g_<4;++g_){ \
      const f32x4_t a_=*(const __attribute__((address_space(3))) f32x4_t*)(kb_+g_*32), b_=*(const __attribute__((address_space(3))) f32x4_t*)(kb_+g_*32+128); \
      P0[4*g_]=a_[0]-mhat;P0[4*g_+1]=a_[1]-mhat;P0[4*g_+2]=a_[2]-mhat;P0[4*g_+3]=a_[3]-mhat; P1[4*g_]=b_[0]-mhat;P1[4*g_+1]=b_[1]-mhat;P1[4*g_+2]=b_[2]-mhat;P1[4*g_+3]=b_[3]-mhat; \
      if(g_&1){asm volatile("":::"memory");} } }while(0)
  bool resc=false;
  #define START(P0,P1) do{ const float rm=rowmax(P0,P1); resc=false; \
    { const float dl=rm; mhat=fadd_s(mhat,dl); \
      _Pragma("unroll") for(int r=0;r<16;++r){P0[r]=fsub_s(P0[r],dl);P1[r]=fsub_s(P1[r],dl);} \
      } \
    _Pragma("unroll") for(int r=0;r<16;++r)P0[r]=__builtin_amdgcn_exp2f(P0[r]); }while(0)
  #define RESC() do{ if(resc){ asm volatile("s_waitcnt lgkmcnt(0)":::"memory"); \
      _Pragma("unroll") for(int d_=0;d_<2;++d_) _Pragma("unroll") for(int r=0;r<16;++r)o[d_][r]*=wsf[crow(r,hi)]; } }while(0)
  f32x16 pA0,pA1,pB0,pB1;
  int sl_prev=0,sl_cur=0,sl_next=SLOTB;
  #define ROT() do{sl_prev=sl_cur;sl_cur=sl_next;sl_next=(sl_next==(NSLOT-1)*SLOTB)?0:sl_next+SLOTB;}while(0)
  DMA_K(2,2*SLOTB);
  WAIT_BAR(3);
  KBIAS(pA0,pA1,0); qkt(pA0,pA1,Kbase,qr,r32,hi);asm volatile("s_nop 15\n\ts_nop 7":"+v"(pA0),"+v"(pA1));CMASK(pA0,pA1,0);
  START(pA0,pA1);
  _Pragma("unroll") for(int r=0;r<16;++r)pA1[r]=__builtin_amdgcn_exp2f(pA1[r]);
  WAIT_BAR(0);
  DMA_K(3,0);DMA_V(1,SLOTB);
  ROT();
  kload8(kf,kp0+sl_cur);
  WAIT_BAR(2);
  s16x4 vlo[8],vhi[8]; u32x4 pw0,pw1,pw2,pw3;
  #define PKW(P,B) cvtpk_s(P[B],P[B+1])
  #define PAF(k) __builtin_bit_cast(bf16x8,pw##k)
  #define VFR(i) (bf16x8){vlo[i][0],vlo[i][1],vlo[i][2],vlo[i][3],vhi[i][0],vhi[i][1],vhi[i][2],vhi[i][3]}
  #define PIN(x) asm volatile("":"+v"(x))
  #define MX3(a,b,c) __builtin_fmaxf(__builtin_fmaxf((a),(b)),(c))
  #define GAPA(MF,A0,A1,A2,A3,W0,W1,PW) do{ MF; sacc+=A0; sacc+=A1; sacc+=A2; sacc+=A3; PIN(sacc); W0; W1; PIN(PW); SBAR(); }while(0)
  #define EX(v) __builtin_amdgcn_exp2f(v)
  #define GAPB(MF,X,B) do{ MF; X[B]=EX(X[B]); X[B+1]=EX(X[B+1]); X[B+2]=EX(X[B+2]); X[B+3]=EX(X[B+3]); PIN(X); SBAR(); }while(0)
  #define VRD(i) do{ vlo[i]=vtr(vp_+(((i)>>2)*4096+((i)&3)*1024)); vhi[i]=vtr(vp_+(((i)>>2)*4096+((i)&3)*1024+512)); }while(0)
  #define KRD(G,j) do{ if(G){ kload2(kf,kp0+sl_next,j); SBAR(); } }while(0)
  #define STEP(C0,C1,P0,P1,t,GK,GV,GL) do{ SBAR(); KBIAS(C0,C1,t); SBAR(); \
    const lds_cptr vp_=vp0+sl_prev; \
    VRD(0); SBAR(); float sacc=(P0[0]+P0[1]); \
    GAPA(C0=__builtin_amdgcn_mfma_f32_32x32x16_bf16(kf[0],qr[0],C0,0,0,0), P0[2],P0[3],P0[4],P0[5],     pw0[0]=PKW(P0,0), pw0[1]=PKW(P0,2), pw0); \
    VRD(4); SBAR(); GAPA(C1=__builtin_amdgcn_mfma_f32_32x32x16_bf16(kf[1],qr[0],C1,0,0,0), P0[6],P0[7],P0[8],P0[9],     pw0[2]=PKW(P0,4), pw0[3]=PKW(P0,6), pw0); \
    VRD(1); SBAR(); GAPA(C0=__builtin_amdgcn_mfma_f32_32x32x16_bf16(kf[2],qr[1],C0,0,0,0),   P0[10],P0[11],P0[12],P0[13], pw1[0]=PKW(P0,8), pw1[1]=PKW(P0,10), pw1); \
    VRD(5); SBAR(); GAPA(C1=__builtin_amdgcn_mfma_f32_32x32x16_bf16(kf[3],qr[1],C1,0,0,0),   P0[14],P0[15],P1[0],P1[1],   pw1[2]=PKW(P0,12),pw1[3]=PKW(P0,14), pw1); \
    VRD(2); SBAR(); GAPA(C0=__builtin_amdgcn_mfma_f32_32x32x16_bf16(kf[4],qr[2],C0,0,0,0),   P1[2],P1[3],P1[4],P1[5],     pw2[0]=PKW(P1,0), pw2[1]=PKW(P1,2), pw2); \
    VRD(6); SBAR(); GAPA(C1=__builtin_amdgcn_mfma_f32_32x32x16_bf16(kf[5],qr[2],C1,0,0,0),   P1[6],P1[7],P1[8],P1[9],     pw2[2]=PKW(P1,4), pw2[3]=PKW(P1,6), pw2); \
    VRD(3); SBAR(); GAPA(C0=__builtin_amdgcn_mfma_f32_32x32x16_bf16(kf[6],qr[3],C0,0,0,0),   P1[10],P1[11],P1[12],P1[13], pw3[0]=PKW(P1,8), pw3[1]=PKW(P1,10), pw3); \
    VRD(7); SBAR(); GAPA(C1=__builtin_amdgcn_mfma_f32_32x32x16_bf16(kf[7],qr[3],C1,0,0,0),   P1[14],P1[15],0.f,0.f,       pw3[2]=PKW(P1,12),pw3[3]=PKW(P1,14), pw3); \
    l_reg+=sacc; \
    if(GK){DMA_K((t)+3,sl_cur);} if(GV){DMA_V((t)+1,sl_next);} \
    CMASK(C0,C1,t); \
    { float a=MX3(C0[0],C0[1],C1[0]),b=MX3(C0[2],C0[3],C1[1]); a=MX3(a,C1[2],C1[3]); \
      _Pragma("unroll") for(int r=4;r<16;r+=4){a=MX3(a,C0[r],C0[r+1]);b=MX3(b,C0[r+2],C0[r+3]);a=MX3(a,C1[r],C1[r+1]);b=MX3(b,C1[r+2],C1[r+3]);} \
      float rm=__builtin_fmaxf(a,b); { auto rr=__builtin_amdgcn_permlane32_swap(__float_as_uint(rm),__float_as_uint(rm),false,false); rm=__builtin_fmaxf(__uint_as_float(rr[0]),__uint_as_float(rr[1])); } \
      resc=false; \
      if(__builtin_expect(__any(rm>(float)THRL),0)){ const float dl=__builtin_fmaxf(rm,0.f); mhat+=dl; \
        _Pragma("unroll") for(int r=0;r<16;++r){C0[r]-=dl;C1[r]-=dl;} \
        const float f=__builtin_amdgcn_exp2f(-dl); l_reg*=f; if(hi==0)wsf[r32]=f; resc=true; } } \
    SBAR(); \
    GAPB(o[0]=__builtin_amdgcn_mfma_f32_32x32x16_bf16(PAF(0),VFR(0),o[0],0,0,0), C0,0); \
    GAPB(o[1]=__builtin_amdgcn_mfma_f32_32x32x16_bf16(PAF(0),VFR(4),o[1],0,0,0), C0,4); \
    KRD(GL,0); GAPB(o[0]=__builtin_amdgcn_mfma_f32_32x32x16_bf16(PAF(1),VFR(1),o[0],0,0,0), C0,8); \
    KRD(GL,1); GAPB(o[1]=__builtin_amdgcn_mfma_f32_32x32x16_bf16(PAF(1),VFR(5),o[1],0,0,0), C0,12); \
    KRD(GL,2); GAPB(o[0]=__builtin_amdgcn_mfma_f32_32x32x16_bf16(PAF(2),VFR(2),o[0],0,0,0), C1,0); \
    KRD(GL,3); GAPB(o[1]=__builtin_amdgcn_mfma_f32_32x32x16_bf16(PAF(2),VFR(6),o[1],0,0,0), C1,4); \
    GAPB(o[0]=__builtin_amdgcn_mfma_f32_32x32x16_bf16(PAF(3),VFR(3),o[0],0,0,0), C1,8); \
    GAPB(o[1]=__builtin_amdgcn_mfma_f32_32x32x16_bf16(PAF(3),VFR(7),o[1],0,0,0), C1,12); \
    }while(0)
  int t=1;
  #undef CMASK
  #define CMASK(P0,P1,t) do{}while(0)
  for(;t+5<NT;t+=2){
    STEP(pB0,pB1,pA0,pA1,t,true,true,true);     WAIT_BAR(2); RESC(); ROT();
    STEP(pA0,pA1,pB0,pB1,t+1,true,true,true);   WAIT_BAR(2); RESC(); ROT();
  }
  #undef CMASK
  #define CMASK(P0,P1,t) do{int jb_=(t)-(NT-4); if(jb_>=0)cmask(P0,P1,jb_,qrel,hi);}while(0)
  #define ENDW(tt) do{ if((tt)+3<NT){WAIT_BAR(2);} else if((tt)+2<NT){WAIT_BAR(1);} else {WAIT_BAR(0);} }while(0)
  for(;t+1<NT;t+=2){
    STEP(pB0,pB1,pA0,pA1,t,(t+3<NT),(t+1<NT),(t+1<NT));       ENDW(t);   RESC(); ROT();
    STEP(pA0,pA1,pB0,pB1,t+1,(t+4<NT),(t+2<NT),(t+2<NT));     ENDW(t+1); RESC(); ROT();
  }
  STEP(pB0,pB1,pA0,pA1,NT-1,false,false,false); RESC();
  { float sacc=pB0[0]+pB0[1]; _Pragma("unroll") for(int r=2;r<16;++r)sacc+=pB0[r]; _Pragma("unroll") for(int r=0;r<16;++r)sacc+=pB1[r]; l_reg+=sacc;
    pw0=(u32x4){PKW(pB0,0),PKW(pB0,2),PKW(pB0,4),PKW(pB0,6)};pw1=(u32x4){PKW(pB0,8),PKW(pB0,10),PKW(pB0,12),PKW(pB0,14)};pw2=(u32x4){PKW(pB1,0),PKW(pB1,2),PKW(pB1,4),PKW(pB1,6)};pw3=(u32x4){PKW(pB1,8),PKW(pB1,10),PKW(pB1,12),PKW(pB1,14)};
    SBAR(); pv(o,vb0+sl_cur,PAF(0),PAF(1),PAF(2),PAF(3)); }
  #undef PKW
  #undef PAF
  #undef VFR
  #undef PIN
  #undef MX3
  #undef GAPA
  #undef GAPB
  #undef EX
  #undef VRD
  #undef KRD
  #undef STEP
  #undef ENDW
  {auto rr=__builtin_amdgcn_permlane32_swap(__float_as_uint(l_reg),__float_as_uint(l_reg),false,false);l_reg=__uint_as_float(rr[0])+__uint_as_float(rr[1]);}
  if(hi==0)wsf[32+r32]=l_reg;asm volatile("s_waitcnt lgkmcnt(0)":::"memory");
  float rli[16];
  #pragma unroll
  for(int r=0;r<16;++r)rli[r]=__builtin_amdgcn_rcpf(wsf[32+crow(r,hi)]);
  bf16*Ow=O+(rowbase+q0+wid*QBLK)*OPITCH+h*D;
  { bf16*stg=(bf16*)(shm+LDS_OST)+wid*2048;
    #pragma unroll
    for(int r=0;r<16;++r){const int orow=crow(r,hi);
      #pragma unroll
      for(int d0=0;d0<2;++d0)stg[orow*64+d0*32+r32]=__float2bfloat16(o[d0][r]*rli[r]);}
    asm volatile("s_waitcnt lgkmcnt(0)":::"memory");
    #pragma unroll
    for(int i=0;i<4;++i){const int row=i*8+(lane>>3),ch=lane&7; const u32x4 v=*(const u32x4*)(stg+row*64+ch*8);
      float x[8]; _Pragma("unroll") for(int j=0;j<4;++j){x[2*j]=__uint_as_float(v[j]<<16);x[2*j+1]=__uint_as_float(v[j]&0xffff0000u);}
      float ss=0.f; _Pragma("unroll") for(int j=0;j<8;++j)ss+=x[j]*x[j];
      ss+=__shfl_xor(ss,1);ss+=__shfl_xor(ss,2);ss+=__shfl_xor(ss,4);
      const float rs=1.0f/sqrtf(ss*(1.0f/64.0f)+1e-5f); const f32x4_t w0=*(const f32x4_t*)(onw+h*D+ch*8),w1=*(const f32x4_t*)(onw+h*D+ch*8+4);
      u32x4 ov; ov[0]=cvtpk_s(x[0]*rs*w0[0],x[1]*rs*w0[1]);ov[1]=cvtpk_s(x[2]*rs*w0[2],x[3]*rs*w0[3]);ov[2]=cvtpk_s(x[4]*rs*w1[0],x[5]*rs*w1[1]);ov[3]=cvtpk_s(x[6]*rs*w1[2],x[7]*rs*w1[3]);
      ATTN_STORE16(Ow+(long)row*OPITCH+ch*8,ov);} }
  asm volatile("s_waitcnt lgkmcnt(0)\n\ts_barrier":::"memory");
  #undef DMA_K
  #undef DMA_V
  #undef CMASK
  #undef KBIAS
  #undef START
  #undef RESC
  #undef ROT
}
constexpr int ATTN_LDS_BYTES=LDS_BYTES;
struct AttnTensors { const bf16* Q; const bf16* K; const bf16* V; bf16* O; const float* kbias; const float* onw; };
struct AttnUnit { int bh; int qb; };
struct StaticOrder {
  int vcu,G;
  __device__ __forceinline__ StaticOrder(int grid,int vcu_):vcu(vcu_),G(grid){}
  __device__ __forceinline__ bool next(int i,AttnUnit&u)const{ const int pi=vcu+G*(i>>1); if(pi>=BATCH*NHEAD*(NQB/2))return false; const int s=pi&3; u.bh=pi>>2; u.qb=(i&1)?(NQB-1-s):s; return true; }
};
template<class Sched,int THRL=8> __device__ __forceinline__ void attn_phase(char*lds,const AttnTensors&T,const Sched&S){
  AttnUnit u;
  for(int i=0;S.next(i,u);++i){ attn_unit<THRL>(u.bh/NHEAD,u.bh%NHEAD,u.qb,T.Q,T.K,T.V,T.O,T.kbias,T.onw,lds); }
}
#undef SBAR
#undef WAIT_BAR
}

constexpr int NWAVES = 8;
#ifndef MK_N_LAUNCHES
#define MK_N_LAUNCHES 1
#endif
constexpr int N_PHASES = 10;
constexpr int N_LAUNCHES = MK_N_LAUNCHES;

constexpr size_t MiB = 1u << 20;
constexpr size_t WS_CTL = 0, CTL_ZERO_BYTES = 1 * MiB;
constexpr size_t WS_WIN = 2 * MiB;
constexpr size_t WS_WOUT = 8 * MiB;
constexpr size_t WS_WGU = 10 * MiB;
constexpr size_t WS_WD = 138 * MiB;
constexpr size_t WS_XN = 202 * MiB;
constexpr size_t WS_T6 = 234 * MiB, T6_STRIDE = 16 * MiB;
constexpr size_t WS_MIX = 330 * MiB;
constexpr size_t WS_GATES = 362 * MiB;
constexpr size_t WS_KBIAS = 364 * MiB;
constexpr size_t WS_MST = 365 * MiB;
constexpr size_t WS_ROUTE = 383 * MiB;
constexpr size_t WS_ACT = 386 * MiB;
constexpr size_t WS_Y = 530 * MiB;
constexpr size_t WS_END = 674 * MiB;
constexpr int MST_PITCH = 2048 + 64;
constexpr size_t RT_TOPI = 0, RT_TOPW = 256 * 1024, RT_HIST = 512 * 1024, RT_POSSLOT = 1024 * 1024, RT_TOKPOS = 1280 * 1024, RT_GATEPOS = 1600 * 1024, RT_TILEPREF = 2048 * 1024;
constexpr int NSEG = MTOK / 64;
static_assert(WS_ACT + (size_t)MAXPOS * DE * 2 <= WS_Y && WS_Y + (size_t)MAXPOS * DMODEL * 2 <= WS_END && WS_MST + (size_t)2048 * MST_PITCH * 4 <= WS_ROUTE, "d_ws map");
constexpr int CW_BAR = 4096;

constexpr int RING_BYTES = 143360;
constexpr int LDSCTL_OFF = RING_BYTES, MISC_OFF = LDSCTL_OFF + 320;
constexpr int LDS_BYTES = 147456;

#define GAS __attribute__((address_space(1)))
#define LAS __attribute__((address_space(3)))
typedef unsigned short bf16;
typedef unsigned v4u __attribute__((ext_vector_type(4)));
typedef float f32x4 __attribute__((ext_vector_type(4)));
typedef short bf16x8 __attribute__((ext_vector_type(8)));
typedef GAS unsigned gu32;
typedef GAS unsigned long long gu64;
#define RLX_AGENT __ATOMIC_RELAXED, __HIP_MEMORY_SCOPE_AGENT
#define LDS_WAIT() asm volatile("s_waitcnt lgkmcnt(0)" ::: "memory")
#define VM_WAIT() asm volatile("s_waitcnt vmcnt(0)" ::: "memory")
__device__ __forceinline__ unsigned long long rt() { return __builtin_amdgcn_s_memrealtime(); }
__device__ __forceinline__ unsigned f2bf(float f) { unsigned u = __builtin_bit_cast(unsigned, f); return (u + 0x7fffu + ((u >> 16) & 1u)) >> 16; }
__device__ __forceinline__ unsigned pk2(float lo, float hi) { return f2bf(lo) | (f2bf(hi) << 16); }

#define XB_TMO      128
#define XB_XCNT(j)  (256  + 64 * (j))
#define XB_XSUB(j)  (1280 + 64 * (j))
#define XB_XGEN(j)  (2304 + 64 * (j))
#define XB_TOP      3328
#define XB_TOPGEN   3392
#define XCD_BAR_WORDS 3456
#define XB_SPIN_CAP (1u << 18)

__device__ __forceinline__ unsigned xb_ld(unsigned* p)              { return __hip_atomic_load(p, __ATOMIC_RELAXED, __HIP_MEMORY_SCOPE_AGENT); }
__device__ __forceinline__ unsigned xb_add(unsigned* p, unsigned v) { return __hip_atomic_fetch_add(p, v, __ATOMIC_RELAXED, __HIP_MEMORY_SCOPE_AGENT); }
__device__ __forceinline__ unsigned xb_xcc_id() { return (unsigned)__builtin_amdgcn_s_getreg((3 << 11) | 20) & 0xFu; }
#define XB_SPIN(cond, bar) do { unsigned _sp = 0; while (cond) { __builtin_amdgcn_s_sleep(1); \
    if ((++_sp & 255u) == 0u) { if (xb_ld(&(bar)[XB_TMO])) break; if (_sp > XB_SPIN_CAP) { atomicAdd(&(bar)[XB_TMO], 1u); break; } } } } while (0)

struct XcdBarrier {
    unsigned* bar; unsigned x;
    volatile LAS unsigned* st;
};

__device__ __forceinline__ XcdBarrier xcd_barrier_post(unsigned* bar, volatile LAS unsigned* st) {
    XcdBarrier b; b.bar = bar; b.x = xb_xcc_id(); b.st = st;
    if (threadIdx.x == 0) (void)xb_add(&bar[XB_XCNT(b.x)], 1u);
    return b;
}
__device__ __forceinline__ void xcd_barrier_complete(unsigned* bar, unsigned x, unsigned& nloc, unsigned& nx) {
    const unsigned G = gridDim.x * gridDim.y * gridDim.z;
    unsigned sum, cnt, mine, sp = 0u;
    for (;;) {
        sum = 0u; cnt = 0u; mine = 0u;
#pragma unroll
        for (unsigned j = 0; j < 16; ++j) { const unsigned c = xb_ld(&bar[XB_XCNT(j)]); sum += c; cnt += (c > 0u) ? 1u : 0u; mine = (j == x) ? c : mine; }
        if (sum == G) break;
        __builtin_amdgcn_s_sleep(1);
        if ((++sp & 255u) == 0u) { if (xb_ld(&bar[XB_TMO])) break; if (sp > XB_SPIN_CAP) { atomicAdd(&bar[XB_TMO], 1u); break; } }
    }
    nloc = mine > 0u ? mine : 1u; nx = cnt > 0u ? cnt : 1u;
}

__device__ __forceinline__ void xcd_barrier(const XcdBarrier& b) {
    asm volatile("s_waitcnt vmcnt(0)" ::: "memory");
    __syncthreads();
    if (threadIdx.x == 0) {
        unsigned* bar = b.bar;
        __builtin_amdgcn_s_waitcnt(0);
        unsigned nloc = b.st[0], nx = b.st[1];
        if (nloc == 0u) { xcd_barrier_complete(bar, b.x, nloc, nx); b.st[0] = nloc; b.st[1] = nx; }
        const unsigned old = xb_add(&bar[XB_XSUB(b.x)], 1u);
        const unsigned gen = old / nloc;
        if (old + 1u == (gen + 1u) * nloc) {
            __builtin_amdgcn_fence(__ATOMIC_RELEASE, "agent");
            asm volatile("s_waitcnt vmcnt(0)" ::: "memory");
            const unsigned og = xb_add(&bar[XB_TOP], 1u);
            const unsigned tg = og / nx;
            if (og + 1u == (tg + 1u) * nx) xb_add(&bar[XB_TOPGEN], 1u);
            else XB_SPIN(xb_ld(&bar[XB_TOPGEN]) == tg, bar);
            __builtin_amdgcn_fence(__ATOMIC_ACQUIRE, "agent");
            xb_add(&bar[XB_XGEN(b.x)], 1u);
            asm volatile("s_waitcnt vmcnt(0)" ::: "memory");
        } else {
            XB_SPIN(xb_ld(&bar[XB_XGEN(b.x)]) == gen, bar);
            __builtin_amdgcn_fence(__ATOMIC_ACQUIRE, "agent");
            asm volatile("s_waitcnt vmcnt(0)" ::: "memory");
        }
    }
    __syncthreads();
}

__device__ __forceinline__ float bf2f(unsigned short x) { return __uint_as_float((unsigned)x << 16); }
__device__ __forceinline__ float bflo(unsigned w) { return __uint_as_float(w << 16); }
__device__ __forceinline__ float bfhi(unsigned w) { return __uint_as_float(w & 0xffff0000u); }
__device__ __forceinline__ float wave_sum(float v) {
#pragma unroll
    for (int o = 1; o < 64; o <<= 1) v += __shfl_xor(v, o);
    return v;
}
__device__ __forceinline__ float wave_max(float v) {
#pragma unroll
    for (int o = 1; o < 64; o <<= 1) v = fmaxf(v, __shfl_xor(v, o));
    return v;
}
__device__ __forceinline__ float wave_scan_sum(float v, int lane) {
#pragma unroll
    for (int o = 1; o < 64; o <<= 1) { const float t = __shfl_up(v, o); if (lane >= o) v += t; }
    return v;
}
__device__ __forceinline__ float wave_scan_max(float v, int lane) {
#pragma unroll
    for (int o = 1; o < 64; o <<= 1) { const float t = __shfl_up(v, o); if (lane >= o) v = fmaxf(v, t); }
    return v;
}
__device__ __forceinline__ float readlane_f(float v, int l) { return __uint_as_float(__builtin_amdgcn_readlane(__float_as_uint(v), l)); }
__device__ __forceinline__ float reduce32(const float (&v)[32], int lane) {
    float a[16], b[8], c[4], d[2];
#pragma unroll
    for (int e = 0; e < 16; ++e) { const float send = (lane & 32) ? v[e] : v[16 + e], keep = (lane & 32) ? v[16 + e] : v[e]; a[e] = keep + __shfl_xor(send, 32); }
#pragma unroll
    for (int e = 0; e < 8; ++e) { const float send = (lane & 16) ? a[e] : a[8 + e], keep = (lane & 16) ? a[8 + e] : a[e]; b[e] = keep + __shfl_xor(send, 16); }
#pragma unroll
    for (int e = 0; e < 4; ++e) { const float send = (lane & 8) ? b[e] : b[4 + e], keep = (lane & 8) ? b[4 + e] : b[e]; c[e] = keep + __shfl_xor(send, 8); }
#pragma unroll
    for (int e = 0; e < 2; ++e) { const float send = (lane & 4) ? c[e] : c[2 + e], keep = (lane & 4) ? c[2 + e] : c[e]; d[e] = keep + __shfl_xor(send, 4); }
    const float send = (lane & 2) ? d[0] : d[1], keep = (lane & 2) ? d[1] : d[0];
    float r = keep + __shfl_xor(send, 2);
    r += __shfl_xor(r, 1);
    return r;
}
__device__ __forceinline__ void fmac_s(float& c, float a, float b) { asm("v_fmac_f32_e32 %0, %1, %2" : "+v"(c) : "v"(a), "v"(b)); }
__device__ __forceinline__ float log_sigmoid(float z) { return fminf(z, 0.f) - log1pf(expf(-fabsf(z))); }

__device__ __forceinline__ void p0_transpose_item(const float* W, int ldw, int src_col0, bf16* WT, int K, size_t dst_row0, int k0, LAS float* scr, int lane) {
#pragma unroll 8
    for (int i = 0; i < 32; ++i) { const int kk = 2 * i + (lane >> 5); scr[kk * 33 + (lane & 31)] = W[(size_t)(k0 + kk) * ldw + src_col0 + (lane & 31)]; }
    LDS_WAIT(); asm volatile("" ::: "memory");
    const int c = lane & 7;
#pragma unroll
    for (int j = 0; j < 4; ++j) { const int n = (lane >> 3) + 8 * j; const LAS float* s = scr + (8 * c) * 33 + n;
        v4u o; o.x = pk2(s[0 * 33], s[1 * 33]); o.y = pk2(s[2 * 33], s[3 * 33]); o.z = pk2(s[4 * 33], s[5 * 33]); o.w = pk2(s[6 * 33], s[7 * 33]);
        *(GAS v4u*)(WT + (dst_row0 + n) * K + k0 + 8 * c) = o; }
    LDS_WAIT(); asm volatile("" ::: "memory");
}
struct P0Args { const float *x, *attn_norm_w, *w_in, *fox_f_bias, *mlstm_i_bias, *mlstm_f_bias, *w_out, *w_gu, *w_d; bf16 *WIN, *WOUT, *WGU, *WD, *XN; float* GATES; };
__device__ __forceinline__ void p0_prologue(const P0Args& A, LAS unsigned char* lds, int vcu, int G, int tid, int lane, int wave) {
    LAS float* scr = (LAS float*)(lds + wave * 16384);
    const int gw = vcu * NWAVES + wave, NGW = G * NWAVES;
    constexpr int NI_IN = 16 * 96, NI_OUT = 16 * 32, NI_GU = NE * 16 * 64, NI_D = NE * 16 * 32, NITEMS = NI_IN + NI_OUT + NI_GU + NI_D;
    for (int it = gw; it < NITEMS; it += NGW) {
        int r = it;
        if (r < NI_IN) { const int kb = r / 96, nb = r % 96, drow = 32 * nb, pn = drow >> 8, p0 = drow & 255, cl = 256 * pn + 64 * ((p0 >> 5) & 3) + 32 * (p0 >> 7);
            const int src = cl + (cl < 1536 ? 0 : (cl < 2560 ? 8 : 24));
            p0_transpose_item(A.w_in, INW, src, A.WIN, DMODEL, (size_t)drow, 64 * kb, scr, lane); continue; }
        r -= NI_IN;
        if (r < NI_OUT) { const int kb = r / 32, nb = r % 32; p0_transpose_item(A.w_out, DMODEL, 32 * nb, A.WOUT, DMODEL, (size_t)(32 * nb), 64 * kb, scr, lane); continue; }
        r -= NI_OUT;
        if (r < NI_GU) { const int e = r / 1024, q = r % 1024, kb = q / 64, nb = q % 64, drow = 32 * nb, pn = drow >> 8, p0 = drow & 255;
            const int src = p0 < 128 ? 128 * pn + p0 : 1024 + 128 * pn + (p0 - 128);
            p0_transpose_item(A.w_gu + (size_t)e * DMODEL * 2048, 2048, src, A.WGU, DMODEL, (size_t)e * 2048 + drow, 64 * kb, scr, lane); continue; }
        r -= NI_GU;
        { const int e = r / 512, q = r % 512, kb = q / 32, nb = q % 32;
            p0_transpose_item(A.w_d + (size_t)e * DE * DMODEL, DMODEL, 32 * nb, A.WD, DE, (size_t)e * 1024 + 32 * nb, 64 * kb, scr, lane); }
    }
    __syncthreads();
    LAS float* gwT = (LAS float*)lds;
    for (int idx = tid; idx < 3 * 1024 * 8; idx += NWAVES * 64) { const int c8 = idx & 7, k = (idx >> 3) & 1023, g3 = idx >> 13; const int base = g3 == 0 ? 1536 : (g3 == 1 ? 2568 : 2576);
        gwT[(8 * g3 + c8) * 1028 + k] = A.w_in[(size_t)k * INW + base + c8]; }
    __syncthreads();
    f32x4 wn[4];
#pragma unroll
    for (int j = 0; j < 4; ++j) wn[j] = *(const f32x4*)(A.attn_norm_w + 4 * lane + 256 * j);
    for (int m = gw; m < MTOK; m += NGW) {
        const GAS f32x4* xr = (const GAS f32x4*)(A.x + (size_t)m * DMODEL) + lane;
        f32x4 v[4]; float s = 0.f;
#pragma unroll
        for (int j = 0; j < 4; ++j) { v[j] = xr[64 * j]; s += (v[j].x * v[j].x + v[j].y * v[j].y) + (v[j].z * v[j].z + v[j].w * v[j].w); }
        const float rstd = 1.f / sqrtf(wave_sum(s) * (1.f / DMODEL) + NORM_EPS);
        GAS unsigned long long* o8 = (GAS unsigned long long*)(A.XN + (size_t)m * DMODEL) + lane;
#pragma unroll
        for (int j = 0; j < 4; ++j) { v[j] = v[j] * rstd * wn[j]; o8[64 * j] = (unsigned long long)pk2(v[j].x, v[j].y) | ((unsigned long long)pk2(v[j].z, v[j].w) << 32); }
        float p[32];
#pragma unroll
        for (int cg = 0; cg < 3; ++cg) {
#pragma unroll
            for (int cc = 0; cc < 8; ++cc) { const int c = cg * 8 + cc; float a = 0.f;
#pragma unroll
                for (int j = 0; j < 4; ++j) { const f32x4 w4 = *(const LAS f32x4*)(gwT + c * 1028 + 256 * j + 4 * lane); a += (v[j].x * w4.x + v[j].y * w4.y) + (v[j].z * w4.z + v[j].w * w4.w); }
                p[c] = a; }
            asm volatile("" ::: "memory");
        }
#pragma unroll
        for (int c = 24; c < 32; ++c) p[c] = 0.f;
        const float val = reduce32(p, lane); const int c = lane >> 1;
        if ((lane & 1) == 0 && c < 24) {
            float o;
            if (c < 8) o = log_sigmoid(val + A.fox_f_bias[c]);
            else if (c < 16) o = val + A.mlstm_i_bias[c - 8];
            else o = log_sigmoid(val + A.mlstm_f_bias[c - 16]);
            A.GATES[(size_t)m * 24 + c] = o;
        }
    }
}

__device__ __forceinline__ void conv_silu32(const bf16* MQK, const float* cw, int cb, long row, int tseq, float (&out)[32]) {
#pragma unroll
    for (int q = 0; q < 4; ++q) {
        float o[8];
#pragma unroll
        for (int i = 0; i < 8; ++i) o[i] = 0.f;
#pragma unroll
        for (int j = 0; j < 4; ++j) {
            v4u w = (v4u){0u, 0u, 0u, 0u};
            if (tseq - 3 + j >= 0) w = *(const GAS v4u*)(MQK + (size_t)(row - 3 + j) * 512 + cb + 8 * q);
            const float* cj = cw + j * 512 + cb + 8 * q;
#pragma unroll
            for (int i = 0; i < 4; ++i) { o[2 * i] += cj[2 * i] * bflo(w[i]); o[2 * i + 1] += cj[2 * i + 1] * bfhi(w[i]); }
        }
#pragma unroll
        for (int i = 0; i < 8; ++i) out[8 * q + i] = o[i] / (1.0f + __expf(-o[i]));
        asm volatile("" ::: "memory"); __builtin_amdgcn_sched_barrier(0);
    }
}
struct MlArgs { const bf16 *MQK, *MV, *MO; const float *GATES, *conv_w, *out_norm_w; float* MST; bf16* MIX; float* KBIAS; };
__device__ __forceinline__ void ml_local_item(const MlArgs& A, int bh, int c, LAS unsigned char* wl, int lane) {
    asm volatile("" : "+v"(lane));
    const int b = bh >> 3, h = bh & 7; const long row = (long)b * SEQ + c * 64 + lane; const int tseq = c * 64 + lane;
    const float fc = A.GATES[(size_t)row * 24 + 16 + h], ic = A.GATES[(size_t)row * 24 + 8 + h];
    const float bcum = wave_scan_sum(fc, lane), blast = readlane_f(bcum, 63);
    const float gg = blast - bcum + ic, a = wave_max(gg), wk = __expf(gg - a);
    float kc[32];
    conv_silu32(A.MQK, A.conv_w, 256 + h * 32, row, tseq, kc);
    LAS float* kw = (LAS float*)wl;
    const float sc = wk * 0.17677669529663687f;
#pragma unroll
    for (int q = 0; q < 8; ++q) *(LAS f32x4*)(kw + lane * 36 + 4 * q) = (f32x4){kc[4 * q] * sc, kc[4 * q + 1] * sc, kc[4 * q + 2] * sc, kc[4 * q + 3] * sc};
    LDS_WAIT(); asm volatile("" ::: "memory");
    float acc[32];
#pragma unroll
    for (int d = 0; d < 32; ++d) acc[d] = 0.f;
    const bf16* vp = A.MV + (size_t)((long)b * SEQ + c * 64) * 512 + h * 64 + lane;
#pragma unroll 2
    for (int t = 0; t < 64; ++t) {
        const float vt = bf2f(vp[(size_t)t * 512]);
#pragma unroll
        for (int q = 0; q < 8; ++q) { const f32x4 k4 = *(const LAS f32x4*)(kw + t * 36 + 4 * q); acc[4 * q] += k4.x * vt; acc[4 * q + 1] += k4.y * vt; acc[4 * q + 2] += k4.z * vt; acc[4 * q + 3] += k4.w * vt; }
    }
    float* st = A.MST + (size_t)(bh * 32 + c) * MST_PITCH;
#pragma unroll
    for (int d = 0; d < 32; ++d) st[d * 64 + lane] = acc[d];
    if (lane < 32) { float n = 0.f; for (int t = 0; t < 64; ++t) n += kw[t * 36 + lane]; st[2048 + lane] = n; }
    if (lane == 0) { st[2048 + 32] = a; st[2048 + 33] = blast; }
    LDS_WAIT(); asm volatile("" ::: "memory");
}
__device__ __forceinline__ void fox_cumsum_item(const MlArgs& A, int bh, int lane) {
    const int b = bh >> 3, h = bh & 7;
    float v[32]; float s = 0.f;
#pragma unroll
    for (int i = 0; i < 32; ++i) { v[i] = A.GATES[(size_t)((long)b * SEQ + lane * 32 + i) * 24 + h]; s += v[i]; v[i] = s; }
    const float excl = wave_scan_sum(s, lane) - s;
    float* o = A.KBIAS + (size_t)bh * SEQ + lane * 32;
#pragma unroll
    for (int q = 0; q < 8; ++q) *(f32x4*)(o + 4 * q) = (f32x4){-(excl + v[4 * q]) * LOG2E, -(excl + v[4 * q + 1]) * LOG2E, -(excl + v[4 * q + 2]) * LOG2E, -(excl + v[4 * q + 3]) * LOG2E};
}
constexpr int ML_WL = 17536;
__device__ __forceinline__ void ml_output_item(const MlArgs& A, int bh, int c, LAS unsigned char* wl, int lane) {
    asm volatile("" : "+v"(lane));
    const int b = bh >> 3, h = bh & 7; const long row0 = (long)b * SEQ + c * 64, row = row0 + lane; const int tseq = c * 64 + lane;
    LAS unsigned char* kL = wl; LAS unsigned char* vL = wl + 4096; LAS unsigned char* cL = wl + 9216; LAS unsigned char* hL = wl + 13312;
    LAS float* nsL = (LAS float*)(wl + 17408);
    const float fc = A.GATES[(size_t)row * 24 + 16 + h], ic = A.GATES[(size_t)row * 24 + 8 + h];
    const float bcum = wave_scan_sum(fc, lane);
    const float beta = ic - bcum, pmax = wave_scan_max(beta, lane);
    const float* stb = A.MST + (size_t)(bh * 32) * MST_PITCH;
    float Bi = 0.f, ai = -INFINITY;
    if (lane < c) { Bi = stb[(size_t)lane * MST_PITCH + 2048 + 33]; ai = stb[(size_t)lane * MST_PITCH + 2048 + 32]; }
    const float PBinc = wave_scan_sum(Bi, lane), ui = (lane < c) ? ai - PBinc : -INFINITY;
    const float Mc = fmaxf(0.f, wave_max(ui)), PBc = readlane_f(PBinc, 63), mprev = PBc + Mc;
    const float wi = (lane < c) ? __expf(ui - Mc) : 0.f;
    const float inter = bcum + mprev, m_t = fmaxf(inter, bcum + pmax), w_inter = __expf(inter - m_t), alpha = bcum - m_t;
    {
        float Cs[32]; float ns = 0.f;
#pragma unroll
        for (int d = 0; d < 32; ++d) Cs[d] = 0.f;
#pragma unroll 1
        for (int i = 0; i < c; ++i) {
            const float w = readlane_f(wi, i); const float* st = stb + (size_t)i * MST_PITCH;
#pragma unroll
            for (int d = 0; d < 32; ++d) fmac_s(Cs[d], w, st[d * 64 + lane]);
            if (lane < 32) ns += w * st[2048 + lane];
        }
#pragma unroll
        for (int d = 0; d < 32; ++d) *(LAS unsigned short*)(cL + d * 128 + lane * 2) = (unsigned short)f2bf(Cs[d]);
        if (lane < 32) nsL[lane] = ns;
    }
    __builtin_amdgcn_sched_barrier(0);
    float q[32];
    { float kc[32]; conv_silu32(A.MQK, A.conv_w, 256 + h * 32, row, tseq, kc);
#pragma unroll
      for (int j = 0; j < 4; ++j) { v4u o;
#pragma unroll
          for (int i = 0; i < 4; ++i) o[i] = pk2(kc[8 * j + 2 * i] * 0.17677669529663687f, kc[8 * j + 2 * i + 1] * 0.17677669529663687f);
          *(LAS v4u*)(kL + lane * 64 + 16 * j) = o; } }
    __builtin_amdgcn_sched_barrier(0);
    conv_silu32(A.MQK, A.conv_w, h * 32, row, tseq, q);
    LDS_WAIT(); asm volatile("" ::: "memory"); __builtin_amdgcn_sched_barrier(0);
    float den = 0.f, dinv = 0.f, ss = 0.f;
    {
        float qn = 0.f;
#pragma unroll
        for (int j = 0; j < 8; ++j) { const f32x4 n4 = *(const LAS f32x4*)(nsL + 4 * j); qn += (q[4 * j] * n4.x + q[4 * j + 1] * n4.y) + (q[4 * j + 2] * n4.z + q[4 * j + 3] * n4.w); }
        den = w_inter * qn;
    }
    float acc[32];
#pragma unroll 1
    for (int eh = 0; eh < 2; ++eh) {
        float wint = w_inter; asm volatile("" : "+v"(wint));
        { const GAS v4u* vp = (const GAS v4u*)(A.MV + (size_t)row * 512 + h * 64 + 32 * eh);
#pragma unroll
          for (int j = 0; j < 4; ++j) *(LAS v4u*)(vL + lane * 80 + 16 * j) = vp[j]; }
#pragma unroll
        for (int e = 0; e < 32; ++e) acc[e] = 0.f;
#pragma unroll
        for (int d = 0; d < 32; ++d) { float qd = q[d] * wint; asm volatile("" : "+v"(qd));
#pragma unroll
            for (int j = 0; j < 4; ++j) { const v4u cv = *(const LAS v4u*)(cL + d * 128 + 64 * eh + 16 * j);
#pragma unroll
                for (int i = 0; i < 4; ++i) { fmac_s(acc[8 * j + 2 * i], qd, bflo(cv[i])); fmac_s(acc[8 * j + 2 * i + 1], qd, bfhi(cv[i])); } }
            if ((d & 1) == 1) { asm volatile("" ::: "memory"); __builtin_amdgcn_sched_barrier(0); } }
        LDS_WAIT(); asm volatile("" ::: "memory");
#pragma unroll 1
        for (int s = 0; s < 64; ++s) {
            float qk = 0.f;
#pragma unroll
            for (int j = 0; j < 4; ++j) { const v4u kv = *(const LAS v4u*)(kL + s * 64 + 16 * j);
#pragma unroll
                for (int i = 0; i < 4; ++i) { fmac_s(qk, q[8 * j + 2 * i], bflo(kv[i])); fmac_s(qk, q[8 * j + 2 * i + 1], bfhi(kv[i])); } }
            const float bs = readlane_f(beta, s);
            const float S = (s <= lane) ? qk * __expf(alpha + bs) : 0.f;
            if (eh == 0) den += S;
#pragma unroll
            for (int j = 0; j < 4; ++j) { const v4u vv = *(const LAS v4u*)(vL + s * 80 + 16 * j);
#pragma unroll
                for (int i = 0; i < 4; ++i) { fmac_s(acc[8 * j + 2 * i], S, bflo(vv[i])); fmac_s(acc[8 * j + 2 * i + 1], S, bfhi(vv[i])); } }
        }
        if (eh == 0) dinv = 1.0f / fmaxf(fabsf(den), __expf(-m_t));
#pragma unroll
        for (int e = 0; e < 32; ++e) { acc[e] *= dinv; ss += acc[e] * acc[e]; }
        if (eh == 0) {
#pragma unroll
            for (int j = 0; j < 4; ++j) { v4u o;
#pragma unroll
                for (int i = 0; i < 4; ++i) o[i] = pk2(acc[8 * j + 2 * i], acc[8 * j + 2 * i + 1]);
                *(LAS v4u*)(hL + lane * 64 + 16 * j) = o; }
        }
        LDS_WAIT(); asm volatile("" ::: "memory"); __builtin_amdgcn_sched_barrier(0);
    }
    const float rstd = 1.0f / sqrtf(ss * (1.0f / 64.0f) + NORM_EPS);
    const GAS v4u* mop = (const GAS v4u*)(A.MO + (size_t)row * 512 + h * 64);
    GAS v4u* op = (GAS v4u*)(A.MIX + (size_t)row * DMODEL + 512 + h * 64);
    const float* wn = A.out_norm_w + h * 64;
#pragma unroll
    for (int j = 0; j < 8; ++j) { const v4u mo = mop[j]; v4u o; v4u h0 = (v4u){0u, 0u, 0u, 0u};
        if (j < 4) h0 = *(const LAS v4u*)(hL + lane * 64 + 16 * j);
#pragma unroll
        for (int i = 0; i < 4; ++i) { const float g0 = 1.0f / (1.0f + __expf(-bflo(mo[i]))), g1 = 1.0f / (1.0f + __expf(-bfhi(mo[i])));
            const float a0 = j < 4 ? bflo(h0[i]) : acc[8 * (j & 3) + 2 * i], a1 = j < 4 ? bfhi(h0[i]) : acc[8 * (j & 3) + 2 * i + 1];
            o[i] = pk2(a0 * rstd * wn[8 * j + 2 * i] * g0, a1 * rstd * wn[8 * j + 2 * i + 1] * g1); }
        op[j] = o; asm volatile("" ::: "memory"); __builtin_amdgcn_sched_barrier(0); }
    LDS_WAIT(); asm volatile("" ::: "memory");
}

struct RtArgs { const float *x1, *moe_norm_w, *router_w, *router_b; bf16* H2; int* TOPI; float* TOPW; int* HIST; };
__device__ __forceinline__ void p5_router(const RtArgs& A, LAS unsigned char* lds, int vcu, int G, int tid, int lane, int wave) {
    LAS float* rwT = (LAS float*)lds;
    LAS int* hist = (LAS int*)(lds + 32 * 1028 * 4);
    for (int idx = tid; idx < DMODEL * NE; idx += NWAVES * 64) { const int e = idx & 31, k = idx >> 5; rwT[e * 1028 + k] = A.router_w[idx]; }
    f32x4 wn[4];
#pragma unroll
    for (int j = 0; j < 4; ++j) wn[j] = *(const f32x4*)(A.moe_norm_w + 4 * lane + 256 * j);
    const float rb = A.router_b[lane >> 1];
    for (int seg = vcu; seg < NSEG; seg += G) {
        if (tid < 32) hist[tid] = 0;
        __syncthreads();
        for (int i = 0; i < 8; ++i) {
            const int m = seg * 64 + wave * 8 + i;
            const GAS f32x4* xr = (const GAS f32x4*)(A.x1 + (size_t)m * DMODEL) + lane;
            f32x4 v[4]; float s = 0.f;
#pragma unroll
            for (int j = 0; j < 4; ++j) { v[j] = xr[64 * j]; s += (v[j].x * v[j].x + v[j].y * v[j].y) + (v[j].z * v[j].z + v[j].w * v[j].w); }
            const float rstd = 1.f / sqrtf(wave_sum(s) * (1.f / DMODEL) + NORM_EPS);
            GAS unsigned long long* o8 = (GAS unsigned long long*)(A.H2 + (size_t)m * DMODEL) + lane;
#pragma unroll
            for (int j = 0; j < 4; ++j) { v[j] = v[j] * rstd * wn[j]; o8[64 * j] = (unsigned long long)pk2(v[j].x, v[j].y) | ((unsigned long long)pk2(v[j].z, v[j].w) << 32); }
            float p[32];
#pragma unroll
            for (int eg = 0; eg < 4; ++eg) {
#pragma unroll
                for (int ee = 0; ee < 8; ++ee) { const int e = eg * 8 + ee; float a = 0.f;
#pragma unroll
                    for (int j = 0; j < 4; ++j) { const f32x4 w4 = *(const LAS f32x4*)(rwT + e * 1028 + 256 * j + 4 * lane); a += (v[j].x * w4.x + v[j].y * w4.y) + (v[j].z * w4.z + v[j].w * w4.w); }
                    p[e] = a; }
                asm volatile("" ::: "memory");
            }
            const float logit = reduce32(p, lane) + rb;
            unsigned ub = __float_as_uint(logit); ub = (ub & 0x80000000u) ? ~ub : (ub | 0x80000000u);
            unsigned long long key = (lane & 1) ? 0ull : (((unsigned long long)ub << 32) | (unsigned)(31 - (lane >> 1)));
            int te[4]; float tv[4];
#pragma unroll
            for (int k = 0; k < 4; ++k) {
                unsigned long long mk = key;
#pragma unroll
                for (int o = 1; o < 64; o <<= 1) { const unsigned lo = __shfl_xor((unsigned)mk, o), hi = __shfl_xor((unsigned)(mk >> 32), o); const unsigned long long ot = ((unsigned long long)hi << 32) | lo; mk = ot > mk ? ot : mk; }
                const int e = 31 - (int)(mk & 0xffffffffu); te[k] = e; tv[k] = readlane_f(logit, 2 * e);
                if (key == mk) key = 0ull;
            }
            const float e1 = __expf(tv[1] - tv[0]), e2 = __expf(tv[2] - tv[0]), e3 = __expf(tv[3] - tv[0]), inv = 1.0f / (1.0f + e1 + e2 + e3);
            if (lane == 0) {
                *(int4*)(A.TOPI + (size_t)m * 4) = make_int4(te[0], te[1], te[2], te[3]);
                *(float4*)(A.TOPW + (size_t)m * 4) = make_float4(inv, e1 * inv, e2 * inv, e3 * inv);
                for (int k = 0; k < 4; ++k) __hip_atomic_fetch_add(hist + te[k], 1, __ATOMIC_RELAXED, __HIP_MEMORY_SCOPE_WORKGROUP);
            }
        }
        __syncthreads();
        if (tid < 32) A.HIST[seg * 32 + tid] = hist[tid];
        __syncthreads();
    }
}

struct DsArgs { const int* TOPI; const float* TOPW; const int* HIST; int* POSSLOT; int* TOKPOS; float* GATEPOS; int* TILEPREF; };
__device__ __forceinline__ void p6_dispatch(const DsArgs& A, LAS unsigned char* lds, int vcu, int G, int tid) {
    LAS int* pb = (LAS int*)lds;
    LAS int* pt = pb + 512;
    LAS int* nE = pt + 512;
    LAS int* base = nE + 32;
    LAS int* pst = base + 32;
    LAS int* es = pst + 64;
    for (int seg = vcu; seg < NSEG; seg += G) {
        { const int e = tid & 31, j = tid >> 5; int below = 0, tot = 0;
          for (int s = 16 * j; s < 16 * j + 16; ++s) { const int hv = A.HIST[s * 32 + e]; tot += hv; if (s < seg) below += hv; }
          pb[j * 32 + e] = below; pt[j * 32 + e] = tot; }
        if (tid < 256) es[tid] = A.TOPI[(size_t)seg * 256 + tid];
        __syncthreads();
        if (tid < 32) { int n = 0, o = 0; for (int j = 0; j < 16; ++j) { n += pt[j * 32 + tid]; o += pb[j * 32 + tid]; } nE[tid] = n; base[tid] = o; }
        __syncthreads();
        if (tid < 32) { int ps = 0; for (int e = 0; e < tid; ++e) ps += (nE[e] + 255) >> 8; pst[tid] = ps * 256; base[tid] += ps * 256;
                        if (tid == 31) pst[32] = (ps + ((nE[31] + 255) >> 8)) * 256; }
        __syncthreads();
        if (tid < 256) {
            const int e = es[tid]; int rank = 0;
            for (int i = 0; i < tid; ++i) rank += (es[i] == e) ? 1 : 0;
            const int pos = base[e] + rank, slot = seg * 256 + tid;
            A.POSSLOT[slot] = pos; A.TOKPOS[pos] = slot >> 2; A.GATEPOS[pos] = A.TOPW[slot];
        }
        if (seg == 0) {
            if (tid <= 32) A.TILEPREF[tid] = pst[tid] >> 8;
            for (int e = 0; e < NE; ++e) { const int p0 = pst[e] + nE[e], p1 = pst[e + 1];
                for (int p = p0 + tid; p < p1; p += NWAVES * 64) { A.TOKPOS[p] = 0; A.GATEPOS[p] = 0.f; } }
        }
        __syncthreads();
    }
}

__device__ __forceinline__ void p9_combine(float* out, const bf16* Y, const int* POSSLOT, int vcu, int G, int lane, int wave) {
    const int gw = vcu * NWAVES + wave, NGW = G * NWAVES;
    for (int m = gw; m < MTOK; m += NGW) {
        const int4 ps = *(const int4*)(POSSLOT + (size_t)m * 4);
        GAS f32x4* xr = (GAS f32x4*)(out + (size_t)m * DMODEL) + lane;
        const GAS unsigned long long* y0 = (const GAS unsigned long long*)(Y + (size_t)ps.x * DMODEL) + lane;
        const GAS unsigned long long* y1 = (const GAS unsigned long long*)(Y + (size_t)ps.y * DMODEL) + lane;
        const GAS unsigned long long* y2 = (const GAS unsigned long long*)(Y + (size_t)ps.z * DMODEL) + lane;
        const GAS unsigned long long* y3 = (const GAS unsigned long long*)(Y + (size_t)ps.w * DMODEL) + lane;
#pragma unroll
        for (int j = 0; j < 4; ++j) {
            f32x4 v = xr[64 * j];
            const unsigned long long a = y0[64 * j], b = y1[64 * j], c = y2[64 * j], d = y3[64 * j];
            v.x += (bflo((unsigned)a) + bflo((unsigned)b)) + (bflo((unsigned)c) + bflo((unsigned)d));
            v.y += (bfhi((unsigned)a) + bfhi((unsigned)b)) + (bfhi((unsigned)c) + bfhi((unsigned)d));
            v.z += (bflo((unsigned)(a >> 32)) + bflo((unsigned)(b >> 32))) + (bflo((unsigned)(c >> 32)) + bflo((unsigned)(d >> 32)));
            v.w += (bfhi((unsigned)(a >> 32)) + bfhi((unsigned)(b >> 32))) + (bfhi((unsigned)(c >> 32)) + bfhi((unsigned)(d >> 32)));
            xr[64 * j] = v;
        }
    }
}

struct Args { const float* in[19]; float* out; unsigned char* ws; int ph_lo, ph_hi, li, pad; };
__global__ void __launch_bounds__(NWAVES * 64, 2) hymba_fwd(Args args) {
    extern __shared__ __attribute__((aligned(16))) unsigned char lds_raw[];
    LAS unsigned char* lds = (LAS unsigned char*)lds_raw;
    volatile LAS unsigned* MISC = (volatile LAS unsigned*)(lds + MISC_OFF);
    const int tid0 = threadIdx.x, wave = __builtin_amdgcn_readfirstlane(tid0 >> 6);
#define PHASE_TID() int tid = tid0; asm volatile("" : "+v"(tid)); const int lane = tid & 63; (void)lane
    const int G = gridDim.x; const int vcu = (G % 8 == 0) ? ((int)blockIdx.x % 8) * (G / 8) + (int)blockIdx.x / 8 : (int)blockIdx.x;
    unsigned char* ws = args.ws;
    gu32* ctl = (gu32*)(ws + WS_CTL);
    for (int u = tid0; u < (LDS_BYTES - LDSCTL_OFF) / 4; u += NWAVES * 64) ((LAS unsigned*)(lds + LDSCTL_OFF))[u] = 0u;
    __syncthreads();
    XcdBarrier bar; bar.bar = (unsigned*)(ctl + CW_BAR); bar.x = 0; bar.st = nullptr;
    if (N_LAUNCHES == 1) bar = xcd_barrier_post((unsigned*)(ctl + CW_BAR), MISC + 8);
#define GRID_BAR() do { if (N_LAUNCHES == 1) xcd_barrier(bar); } while (0)
    const int lo = args.ph_lo, hi = args.ph_hi;
#ifndef PHASE_MASK
#define PHASE_MASK 0x3ff
#endif
#define IN(k) (((PHASE_MASK >> (k)) & 1) && lo <= (k) && (k) < hi)
#define BOTH(k) (IN(k) && IN((k) + 1))
    const float* x = args.in[0];
    bf16* WIN = (bf16*)(ws + WS_WIN); bf16* WOUT = (bf16*)(ws + WS_WOUT); bf16* WGU = (bf16*)(ws + WS_WGU); bf16* WD = (bf16*)(ws + WS_WD);
    bf16* XN = (bf16*)(ws + WS_XN); bf16* T6 = (bf16*)(ws + WS_T6); bf16* MIX = (bf16*)(ws + WS_MIX);
    float* GATES = (float*)(ws + WS_GATES); float* KBIAS = (float*)(ws + WS_KBIAS); float* MST = (float*)(ws + WS_MST);
    unsigned char* rt_ = ws + WS_ROUTE;
    int* TOPI = (int*)(rt_ + RT_TOPI); float* TOPW = (float*)(rt_ + RT_TOPW); int* HIST = (int*)(rt_ + RT_HIST); int* POSSLOT = (int*)(rt_ + RT_POSSLOT);
    int* TOKPOS = (int*)(rt_ + RT_TOKPOS); float* GATEPOS = (float*)(rt_ + RT_GATEPOS); int* TILEPREF = (int*)(rt_ + RT_TILEPREF);
    bf16* ACT = (bf16*)(ws + WS_ACT); bf16* Y = (bf16*)(ws + WS_Y);
    const MlArgs ML{T6 + 3 * (T6_STRIDE / 2), T6 + 4 * (T6_STRIDE / 2), T6 + 5 * (T6_STRIDE / 2), GATES, args.in[7], args.in[10], MST, MIX, KBIAS};

    if (IN(0)) {
        PHASE_TID();
        const P0Args A{x, args.in[1], args.in[2], args.in[3], args.in[8], args.in[9], args.in[11], args.in[15], args.in[17], WIN, WOUT, WGU, WD, XN, GATES};
        p0_prologue(A, lds, vcu, G, tid, lane, wave);
        if (BOTH(0)) GRID_BAR();
    }
    if (IN(1)) {
        pg8::Gemm g{XN, WIN, DMODEL, nullptr}; pg8::StaticOrder S; S.init(MTOK, 3072, G, (int)blockIdx.x);
        pg8::EpiInProj E{T6, T6_STRIDE / 2, args.in[4], args.in[5]};
        pg8::gemm_phase<pg8::EpiInProj, pg8::StaticOrder, true, false>(lds, g, S, E);
        if (BOTH(1)) GRID_BAR();
    }
    if (IN(2)) {
        PHASE_TID();
        LAS unsigned char* wl = lds + wave * 9216;
        for (int it = vcu * NWAVES + wave; it < 2048 + 64; it += G * NWAVES) {
            if (it < 2048) ml_local_item(ML, it >> 5, it & 31, wl, lane);
            else fox_cumsum_item(ML, it - 2048, lane);
        }
        if (BOTH(2)) GRID_BAR();
    }
    if (IN(3)) {
        const attn_body::AttnTensors AT{(const attn_body::bf16*)T6, (const attn_body::bf16*)(T6 + T6_STRIDE / 2), (const attn_body::bf16*)(T6 + 2 * (T6_STRIDE / 2)), (attn_body::bf16*)MIX, KBIAS, args.in[6]};
        const attn_body::StaticOrder S(G, vcu);
        attn_body::attn_phase<attn_body::StaticOrder>((char*)lds_raw, AT, S);
        __syncthreads();
        PHASE_TID();
        LAS unsigned char* wl = lds + wave * ML_WL;
        for (int v = vcu; v < 256; v += G) {
            const int pair = v & 15, bh = (v >> 4) * 4 + (wave >> 1), c = (wave & 1) ? 31 - pair : pair;
            ml_output_item(ML, bh, c, wl, lane);
        }
        if (BOTH(3)) GRID_BAR();
    }
    if (IN(4)) {
        pg8::Gemm g{MIX, WOUT, DMODEL, nullptr}; pg8::StaticOrder S; S.init(MTOK, DMODEL, G, (int)blockIdx.x);
        pg8::EpiResid E{x, args.out, DMODEL};
        pg8::gemm_phase<pg8::EpiResid, pg8::StaticOrder, true, false>(lds, g, S, E);
        if (BOTH(4)) GRID_BAR();
    }
    if (IN(5)) {
        PHASE_TID();
        const RtArgs A{args.out, args.in[12], args.in[13], args.in[14], XN, TOPI, TOPW, HIST};
        p5_router(A, lds, vcu, G, tid, lane, wave);
        if (BOTH(5)) GRID_BAR();
    }
    if (IN(6)) {
        PHASE_TID();
        const DsArgs A{TOPI, TOPW, HIST, POSSLOT, TOKPOS, GATEPOS, TILEPREF};
        p6_dispatch(A, lds, vcu, G, tid);
        if (BOTH(6)) GRID_BAR();
    }
    if (IN(7)) {
        pg8::Gemm g{XN, WGU, DMODEL, TOKPOS}; pg8::MoeOrder S; S.init(TILEPREF, 8, G, (int)blockIdx.x);
        pg8::EpiSwiGLU E{ACT, args.in[16]};
        pg8::gemm_phase<pg8::EpiSwiGLU, pg8::MoeOrder, true, true>(lds, g, S, E);
        if (BOTH(7)) GRID_BAR();
    }
    if (IN(8)) {
        pg8::Gemm g{ACT, WD, DE, nullptr}; pg8::MoeOrder S; S.init(TILEPREF, 4, G, (int)blockIdx.x);
        pg8::EpiDown E{Y, args.in[18], GATEPOS};
        pg8::gemm_phase<pg8::EpiDown, pg8::MoeOrder, true, false>(lds, g, S, E);
        if (BOTH(8)) GRID_BAR();
    }
    if (IN(9)) { PHASE_TID(); p9_combine(args.out, Y, POSSLOT, vcu, G, lane, wave); }
#undef IN
#undef BOTH
#undef GRID_BAR
}

extern "C" void kernel_launch(void* const* d_in, const int* in_sizes, int n_in, void* d_out, int out_size, void* d_ws, size_t ws_size, hipStream_t stream) {
    static int grid = 0;
    if (grid == 0) {
        if (n_in != 19 || in_sizes[0] != MTOK * DMODEL || out_size != MTOK * DMODEL || ws_size < WS_END) { fprintf(stderr, "kernel_launch: unexpected shapes (n_in %d, in0 %d, out %d, ws %zu); nothing launched\n", n_in, n_in > 0 ? in_sizes[0] : -1, out_size, ws_size); grid = -1; return; }
        int dev = 0, cus = 0, per_cu = 0;
        if (hipGetDevice(&dev) != hipSuccess || hipDeviceGetAttribute(&cus, hipDeviceAttributeMultiprocessorCount, dev) != hipSuccess) { grid = -1; return; }
        if (hipFuncSetAttribute((const void*)hymba_fwd, hipFuncAttributeMaxDynamicSharedMemorySize, LDS_BYTES) != hipSuccess) { fprintf(stderr, "kernel_launch: hipFuncSetAttribute failed\n"); grid = -1; return; }
        if (hipOccupancyMaxActiveBlocksPerMultiprocessor(&per_cu, (const void*)hymba_fwd, NWAVES * 64, LDS_BYTES) != hipSuccess || per_cu < 1) { fprintf(stderr, "kernel_launch: occupancy query reports %d workgroups per CU; nothing launched\n", per_cu); (void)hipGetLastError(); grid = -1; return; }
        (void)hipGetLastError();
        grid = cus;
    }
    if (grid < 0) return;
    if (hipMemsetAsync((char*)d_ws + WS_CTL, 0, CTL_ZERO_BYTES, stream) != hipSuccess) return;
    Args a{};
    for (int i = 0; i < 19; ++i) a.in[i] = (const float*)d_in[i];
    a.out = (float*)d_out; a.ws = (unsigned char*)d_ws;
    for (int li = 0; li < N_LAUNCHES; ++li) {
        a.ph_lo = (N_LAUNCHES == 1) ? 0 : li; a.ph_hi = (N_LAUNCHES == 1) ? N_PHASES : li + 1; a.li = li;
        hipLaunchKernelGGL(hymba_fwd, dim3(grid), dim3(NWAVES * 64), LDS_BYTES, stream, a);
        const hipError_t le = hipPeekAtLastError();
        if (le != hipSuccess) { fprintf(stderr, "kernel_launch: launch %d failed: %s\n", li, hipGetErrorName(le)); break; }
    }
}
```

```cpp
#include <hip/hip_runtime.h>
#include <hip/hip_bf16.h>
#include <cstdio>
#include <cstdint>
#include <cmath>

constexpr int BATCH = 8, SEQ = 2048, DMODEL = 1024, MTOK = BATCH * SEQ;
constexpr int FH = 8, HD = 64, MH = 8, MQKD = 32, MVD = 64;
constexpr int INW = 3096;
constexpr int NE = 32, TOPK = 4, DE = 1024;
constexpr int NSLOT = MTOK * TOPK;
constexpr int MAXPOS = NSLOT + NE * 256;
constexpr float NORM_EPS = 1e-5f;
constexpr float LOG2E = 1.4426950408889634f;
constexpr float QSCALE = 0.125f * LOG2E;

namespace pg8 {
#define PG8_LAS __attribute__((address_space(3)))
typedef unsigned short bf16_t;
typedef short bf16x8 __attribute__((ext_vector_type(8)));
typedef float f32x4 __attribute__((ext_vector_type(4)));
typedef unsigned u32x4 __attribute__((ext_vector_type(4)));
typedef unsigned u32x2 __attribute__((ext_vector_type(2)));
typedef int i32x4 __attribute__((ext_vector_type(4)));
typedef int i32x8 __attribute__((ext_vector_type(8)));
constexpr int BM = 256, BK = 64, HALF = 128, HTB = HALF * BK * 2  , STAGE_BYTES = 8 * HTB, NXCD = 8, WGM = 8;

__host__ __device__ __forceinline__ int lds_byte(int r, int c) { const int st = (r >> 4) * 2 + (c >> 5), rr = r & 15, cc = c & 31, ob = rr * 64 + cc * 2; return st * 1024 + (ob ^ (((ob >> 9) & 1) << 5)); }
__host__ __device__ __forceinline__ void stage_rc(int b, int& R, int& C) { const int st = b / 1024, sb = b % 1024, swz = sb ^ (((sb >> 9) & 1) << 5); R = (st >> 1) * 16 + swz / 64; C = (st & 1) * 32 + (swz % 64) / 2; }
__host__ __device__ __forceinline__ int perm32(int rho) { const int n = rho >> 4, i = rho & 15; return 8 * (i >> 2) + 4 * n + (i & 3); }

struct Unit { int pm, pn; };
struct Gemm { const bf16_t* A; const bf16_t* Bt; int K; const int* rowidx; const unsigned* ready; unsigned need; unsigned long long* tprobe = nullptr; };

struct StaticOrder {
    int nM, nN, nwg, G, c;
    __host__ __device__ void init(int M, int N, int G_, int c_) { nM = M / BM; nN = N / BM; nwg = nM * nN; G = G_; c = c_; }
    __host__ __device__ bool next(int i, Unit& u) const {
        const long L = (long)i * G + c; if (L >= nwg) return false;
        int wgid = (int)L; { const int q = nwg / NXCD, r = nwg % NXCD, xcd = wgid % NXCD, off = wgid / NXCD; wgid = (xcd < r ? xcd * (q + 1) : r * (q + 1) + (xcd - r) * q) + off; }
        const int nig = WGM * nN, gid = wgid / nig, fm = gid * WGM, gsz = (nM - fm) < WGM ? (nM - fm) : WGM;
        u.pm = fm + ((wgid % nig) % gsz); u.pn = (wgid % nig) / gsz; return true;
    }
};
struct MoeOrder {
    volatile PG8_LAS int* tb; int npn, nb, rank, total, off, r0;
    __device__ void init(const int* tp_, int npn_, int G_, int c_, int isdown, volatile PG8_LAS int* tb_) { tb = tb_; npn = npn_; const int cc = (G_ % 8 == 0) ? (c_ % 8) * (G_ / 8) + c_ / 8 : c_;
        nb = G_ / 8; const int x = cc / nb; rank = cc % nb; int cum = 0;
        for (int j = 0; j < 4; ++j) { const int e = tp_[33 + x + 8 * j], t0 = tp_[e], m = tp_[e + 1] - t0; cum += m; if (threadIdx.x == 0) { tb_[j] = e; tb_[4 + j] = t0; tb_[8 + j] = cum; } }
        total = cum * npn_; off = isdown ? 8 * cum : 0;
        r0 = (off > rank) ? (off - rank + nb - 1) / nb : 0; }
    __device__ bool next(int i, Unit& u) const {
        const int U = (r0 + i) * nb + rank - off; if (U >= total) return false;
        const int c1 = tb[8] * npn, c2 = tb[9] * npn, c3 = tb[10] * npn;
        const int j = (U >= c3) ? 3 : (U >= c2) ? 2 : (U >= c1) ? 1 : 0, base = j == 3 ? c3 : (j == 2 ? c2 : (j == 1 ? c1 : 0));
        const int e = tb[j], w = U - base;
        u.pm = tb[4 + j] + (w / npn); u.pn = e * npn + (w % npn); return true;
    }
};

__device__ __forceinline__ unsigned cvt_pk_bf16(float lo, float hi) { unsigned r; asm volatile("v_cvt_pk_bf16_f32 %0, %1, %2" : "=v"(r) : "v"(lo), "v"(hi)); return r; }

struct EpiInProj {
    static constexpr bool PERM = true;
    bf16_t* base; size_t tstride; const float* wq; const float* wk;
    __device__ __forceinline__ void operator()(const f32x4 (&acc)[2][2][4][2], const Unit& u, int wr, int wc, int fr, int fq) const {
        const int tt = u.pn >> 1, row0 = u.pm * BM + wr * 64 + fr, colb = (u.pn & 1) * 256 + 64 * wc + 8 * fq;
        bf16_t* T = base + (size_t)tt * tstride;
        if (tt <= 1) {
            const float* w = tt == 0 ? wq : wk; const float sc = tt == 0 ? QSCALE : 1.0f;
            f32x4 wv[2][2];
#pragma unroll
            for (int bj = 0; bj < 2; ++bj)
#pragma unroll
                for (int n = 0; n < 2; ++n) wv[bj][n] = *(const f32x4*)(w + 32 * bj + 8 * fq + 4 * n) * sc;
#pragma unroll
            for (int ai = 0; ai < 2; ++ai)
#pragma unroll
                for (int m = 0; m < 4; ++m) {
                    float ss = 0.f;
#pragma unroll
                    for (int bj = 0; bj < 2; ++bj)
#pragma unroll
                        for (int n = 0; n < 2; ++n) { const f32x4 x = acc[ai][bj][m][n]; ss += (x[0] * x[0] + x[1] * x[1]) + (x[2] * x[2] + x[3] * x[3]); }
                    ss += __shfl_xor(ss, 16); ss += __shfl_xor(ss, 32);
                    const float rstd = 1.0f / sqrtf(ss * (1.0f / 64.0f) + NORM_EPS);
                    bf16_t* rowp = T + (size_t)(row0 + ai * HALF + m * 16) * 512 + colb;
#pragma unroll
                    for (int bj = 0; bj < 2; ++bj) { const f32x4 v0 = acc[ai][bj][m][0] * rstd * wv[bj][0], v1 = acc[ai][bj][m][1] * rstd * wv[bj][1];
                        u32x4 o; o.x = cvt_pk_bf16(v0[0], v0[1]); o.y = cvt_pk_bf16(v0[2], v0[3]); o.z = cvt_pk_bf16(v1[0], v1[1]); o.w = cvt_pk_bf16(v1[2], v1[3]);
                        *(u32x4*)(rowp + 32 * bj) = o; }
                }
        } else {
#pragma unroll
            for (int ai = 0; ai < 2; ++ai)
#pragma unroll
                for (int m = 0; m < 4; ++m) { bf16_t* rowp = T + (size_t)(row0 + ai * HALF + m * 16) * 512 + colb;
#pragma unroll
                    for (int bj = 0; bj < 2; ++bj) { const f32x4 v0 = acc[ai][bj][m][0], v1 = acc[ai][bj][m][1];
                        u32x4 o; o.x = cvt_pk_bf16(v0[0], v0[1]); o.y = cvt_pk_bf16(v0[2], v0[3]); o.z = cvt_pk_bf16(v1[0], v1[1]); o.w = cvt_pk_bf16(v1[2], v1[3]);
                        *(u32x4*)(rowp + 32 * bj) = o; } }
        }
    }
};
struct EpiResid {
    static constexpr bool PERM = true;
    bf16_t* out; int ldc;
    __device__ __forceinline__ void operator()(const f32x4 (&acc)[2][2][4][2], const Unit& u, int wr, int wc, int fr, int fq) const {
        const int row0 = u.pm * BM + wr * 64 + fr, col0 = u.pn * BM + wc * 32 + 8 * fq;
#pragma unroll
        for (int ai = 0; ai < 2; ++ai)
#pragma unroll
            for (int m = 0; m < 4; ++m) { const size_t off = (size_t)(row0 + ai * HALF + m * 16) * ldc + col0;
#pragma unroll
                for (int bj = 0; bj < 2; ++bj) { const f32x4 v0 = acc[ai][bj][m][0], v1 = acc[ai][bj][m][1];
                    u32x4 o; o.x = cvt_pk_bf16(v0[0], v0[1]); o.y = cvt_pk_bf16(v0[2], v0[3]); o.z = cvt_pk_bf16(v1[0], v1[1]); o.w = cvt_pk_bf16(v1[2], v1[3]);
                    *(u32x4*)(out + off + bj * HALF) = o; } }
    }
};
struct EpiSwiGLU {
    static constexpr bool PERM = true;
    unsigned char* act; const float* bgu; unsigned* done;
    __device__ __forceinline__ void operator()(const f32x4 (&acc)[2][2][4][2], const Unit& u, int wr, int wc, int fr, int fq) const {
        const int e = u.pn >> 3, pnl = u.pn & 7, row0 = u.pm * BM + wr * 64 + fr, colg = 128 * pnl + 32 * wc + 8 * fq;
        f32x4 bg[2], bu[2];
#pragma unroll
        for (int n = 0; n < 2; ++n) { bg[n] = *(const f32x4*)(bgu + (size_t)e * 2048 + colg + 4 * n); bu[n] = *(const f32x4*)(bgu + (size_t)e * 2048 + 1024 + colg + 4 * n); }
#pragma unroll
        for (int ai = 0; ai < 2; ++ai)
#pragma unroll
            for (int m = 0; m < 4; ++m) {
                unsigned w[2];
#pragma unroll
                for (int n = 0; n < 2; ++n) { const f32x4 g4 = acc[ai][0][m][n] + bg[n], u4 = acc[ai][1][m][n] + bu[n]; float r[4];
#pragma unroll
                    for (int i = 0; i < 4; ++i) { const float g = fminf(g4[i], 7.0f), uu = fminf(fmaxf(u4[i], -7.0f), 7.0f);
                        const float sg = __builtin_amdgcn_rcpf(1.0f + __builtin_amdgcn_exp2f(-1.702f * LOG2E * g)); r[i] = (uu + 1.0f) * (g * sg); }
                    int pk = __builtin_amdgcn_cvt_pk_fp8_f32(r[0], r[1], 0, false); pk = __builtin_amdgcn_cvt_pk_fp8_f32(r[2], r[3], pk, true); w[n] = (unsigned)pk; }
                __hip_atomic_store((unsigned long long*)(act + (size_t)(row0 + ai * HALF + m * 16) * DE + colg), (unsigned long long)w[0] | ((unsigned long long)w[1] << 32), __ATOMIC_RELAXED, __HIP_MEMORY_SCOPE_AGENT);
            }
        asm volatile("s_waitcnt vmcnt(0)" ::: "memory");
        if (fr == 0 && fq == 0) __hip_atomic_fetch_add(done + 64 * u.pm, 1u, __ATOMIC_RELAXED, __HIP_MEMORY_SCOPE_AGENT);
    }
};
struct EpiDown {
    static constexpr bool PERM = true;
    unsigned char* y; const float* bd; const float* gate;
    __device__ __forceinline__ void operator()(const f32x4 (&acc)[2][2][4][2], const Unit& u, int wr, int wc, int fr, int fq) const {
        const int e = u.pn >> 2, pnl = u.pn & 3, row0 = u.pm * BM + wr * 64 + fr, col0 = 256 * pnl + 32 * wc + 8 * fq;
        f32x4 bv[2][2];
#pragma unroll
        for (int bj = 0; bj < 2; ++bj)
#pragma unroll
            for (int n = 0; n < 2; ++n) bv[bj][n] = *(const f32x4*)(bd + (size_t)e * DMODEL + col0 + bj * HALF + 4 * n);
#pragma unroll
        for (int ai = 0; ai < 2; ++ai)
#pragma unroll
            for (int m = 0; m < 4; ++m) { const int row = row0 + ai * HALF + m * 16; const float gw = gate[row]; unsigned char* rowp = y + (size_t)row * DMODEL + col0;
#pragma unroll
                for (int bj = 0; bj < 2; ++bj) { const f32x4 v0 = (acc[ai][bj][m][0] + bv[bj][0]) * gw, v1 = (acc[ai][bj][m][1] + bv[bj][1]) * gw;
                    int p0 = __builtin_amdgcn_cvt_pk_fp8_f32(v0[0], v0[1], 0, false); p0 = __builtin_amdgcn_cvt_pk_fp8_f32(v0[2], v0[3], p0, true);
                    int p1 = __builtin_amdgcn_cvt_pk_fp8_f32(v1[0], v1[1], 0, false); p1 = __builtin_amdgcn_cvt_pk_fp8_f32(v1[2], v1[3], p1, true);
                    u32x2 o; o.x = (unsigned)p0; o.y = (unsigned)p1; *(u32x2*)(rowp + bj * HALF) = o; } }
    }
};

constexpr int F8_SCALE_W = 0x7A7A7A7A, F8_SCALE_X = 0x7F7F7F7F;
template <class Epi, class Sched, bool ALIGN_EPI, bool GATHER, bool FP8 = false, bool DEP = false>
__device__ __forceinline__ void gemm_phase(PG8_LAS unsigned char* lds, const Gemm g, const Sched& S, const Epi& E) {
    const int tid = threadIdx.x, wid = __builtin_amdgcn_readfirstlane(tid >> 6), lane = tid & 63, wr = wid >> 2, wc = wid & 3, fr = lane & 15, fq = lane >> 4;
    const int K = g.K, nt = K / BK;
    unsigned voffA[2], voffB[2]; int RA[2], CA[2];
#pragma unroll
    for (int i = 0; i < 2; ++i) { int R, C; stage_rc(tid * 16 + i * 8192, R, C); const int Rb = Epi::PERM ? ((R & ~31) + perm32(R & 31)) : R;
        RA[i] = R; CA[i] = C; voffA[i] = (unsigned)(R * K + C) * 2u; voffB[i] = (unsigned)(Rb * K + C) * 2u; }
    const size_t kstep = (size_t)(BK * 2);
    const size_t hstep = (size_t)HALF * K * 2;
    const size_t tstep = 2 * hstep;
    const unsigned ldsw = (unsigned)wid * 1024u;
    const int aoff = lds_byte(wr * 64 + fr, fq * 8), boff = lds_byte(wc * 32 + fr, fq * 8);
#define PG8_SA(b, h) (((b) * 2 + (h)) * HTB)
#define PG8_SB(b, h) ((4 + (b) * 2 + (h)) * HTB)
#define PG8_STAGE(bufoff, gbase, voff) do { _Pragma("unroll") for (int _i = 0; _i < 2; ++_i) \
        __builtin_amdgcn_global_load_lds((const unsigned*)((const char*)(gbase) + (voff)[_i]), (PG8_LAS unsigned*)(lds + (bufoff) + ldsw + _i * 8192), 16, 0, 0); } while (0)
#define PG8_STAGE_A(bufoff, p, h, vg) do { if constexpr (GATHER) { PG8_STAGE(bufoff, p, (vg)[h]); } else { PG8_STAGE(bufoff, (p) + (h) * hstep, voffA); } } while (0)
#define PG8_LD8(p_) __builtin_shufflevector(*(const PG8_LAS i32x4*)(p_), *(const PG8_LAS i32x4*)((p_) + 1024), 0, 1, 2, 3, 4, 5, 6, 7)
#define PG8_LDA(dst, b, h) do { if constexpr (FP8) { _Pragma("unroll") for (int m = 0; m < 4; ++m) dst##8[m] = PG8_LD8(lds + PG8_SA(b, h) + aoff + m * 2048); } else { \
        _Pragma("unroll") for (int m = 0; m < 4; ++m) _Pragma("unroll") for (int k = 0; k < 2; ++k) dst[m][k] = *(const PG8_LAS bf16x8*)(lds + PG8_SA(b, h) + aoff + m * 2048 + k * 1024); } } while (0)
#define PG8_LDB(dst, b, h) do { if constexpr (FP8) { _Pragma("unroll") for (int n = 0; n < 2; ++n) dst##8[n] = PG8_LD8(lds + PG8_SB(b, h) + boff + n * 2048); } else { \
        _Pragma("unroll") for (int n = 0; n < 2; ++n) _Pragma("unroll") for (int k = 0; k < 2; ++k) dst[n][k] = *(const PG8_LAS bf16x8*)(lds + PG8_SB(b, h) + boff + n * 2048 + k * 1024); } } while (0)
#define PG8_MMA(ai, bj, At, Bt) do { __builtin_amdgcn_s_setprio(1); if constexpr (FP8) { _Pragma("unroll") for (int m = 0; m < 4; ++m) _Pragma("unroll") for (int n = 0; n < 2; ++n) \
        asm volatile("v_mfma_scale_f32_16x16x128_f8f6f4 %0, %1, %2, %0, %3, %4 op_sel_hi:[0,0,0]" : "+v"(acc[ai][bj][m][n]) : "v"(Bt##8[n]), "v"(At##8[m]), "v"(f8sw), "v"(f8sx)); } else { \
        _Pragma("unroll") for (int m = 0; m < 4; ++m) _Pragma("unroll") for (int n = 0; n < 2; ++n) _Pragma("unroll") for (int k = 0; k < 2; ++k) \
        acc[ai][bj][m][n] = __builtin_amdgcn_mfma_f32_16x16x32_bf16(Bt[n][k], At[m][k], acc[ai][bj][m][n], 0, 0, 0); } __builtin_amdgcn_s_setprio(0); } while (0)
#define PG8_WAIT_V(n) asm volatile("s_waitcnt vmcnt(" #n ")" ::: "memory")
#define PG8_WAIT_L(n) asm volatile("s_waitcnt lgkmcnt(" #n ")" ::: "memory")
#define PG8_BAR __builtin_amdgcn_s_barrier()
#define PG8_SCHED __builtin_amdgcn_sched_barrier(0)
    Unit cur, nxt; int ui = 0; unsigned long long epi_t_ = 0ull;
    if (!S.next(0, cur)) return;
#define PG8_PEEK(pm_) ((unsigned)__builtin_amdgcn_readfirstlane((int)__hip_atomic_load(g.ready + 64 * (pm_), __ATOMIC_RELAXED, __HIP_MEMORY_SCOPE_AGENT)))
#define PG8_WAIT_READY(pm_) do { unsigned sp_ = 0; while (PG8_PEEK(pm_) < g.need && ++sp_ < (1u << 22)) __builtin_amdgcn_s_sleep(2); } while (0)
    if constexpr (DEP) PG8_WAIT_READY(cur.pm);
    f32x4 acc[2][2][4][2];
#pragma unroll
    for (int a = 0; a < 2; ++a)
#pragma unroll
        for (int b = 0; b < 2; ++b)
#pragma unroll
            for (int m = 0; m < 4; ++m)
#pragma unroll
                for (int n = 0; n < 2; ++n) acc[a][b][m][n] = (f32x4){0.f, 0.f, 0.f, 0.f};
    bf16x8 At[4][2], B0[2][2], B1[2][2];
    i32x8 At8[4], B08[2], B18[2];
    int f8sw = F8_SCALE_W, f8sx = F8_SCALE_X; asm volatile("" : "+v"(f8sw), "+v"(f8sx));
    unsigned vgC[2][2], vgN[2][2];
    if constexpr (GATHER) {
#pragma unroll
        for (int h = 0; h < 2; ++h)
#pragma unroll
            for (int i = 0; i < 2; ++i) { vgC[h][i] = ((unsigned)g.rowidx[cur.pm * BM + h * HALF + RA[i]] * (unsigned)K + (unsigned)CA[i]) * 2u; vgN[h][i] = vgC[h][i]; }
    }
    const char* cA = GATHER ? (const char*)g.A : (const char*)g.A + (size_t)cur.pm * tstep; const char* cB = (const char*)g.Bt + (size_t)cur.pn * tstep;
    PG8_STAGE(PG8_SB(0, 0), cB, voffB); PG8_STAGE(PG8_SB(0, 1), cB + hstep, voffB); PG8_STAGE_A(PG8_SA(0, 0), cA, 0, vgC); PG8_STAGE_A(PG8_SA(0, 1), cA, 1, vgC);
    if (wr == 1) PG8_BAR;
    PG8_WAIT_V(2); PG8_BAR;
    PG8_STAGE(PG8_SB(1, 0), cB + kstep, voffB); PG8_STAGE_A(PG8_SA(1, 0), cA + kstep, 0, vgC); PG8_STAGE(PG8_SB(1, 1), cB + hstep + kstep, voffB);
    PG8_WAIT_V(6); PG8_BAR;
    for (;;) {
        const bool has_next = S.next(ui + 1, nxt);
        unsigned peek = 0u; if constexpr (DEP) { if (has_next) peek = PG8_PEEK(nxt.pm); }
        if constexpr (GATHER) { if (has_next) {
#pragma unroll
            for (int h = 0; h < 2; ++h)
#pragma unroll
                for (int i = 0; i < 2; ++i) vgN[h][i] = ((unsigned)g.rowidx[nxt.pm * BM + h * HALF + RA[i]] * (unsigned)K + (unsigned)CA[i]) * 2u; } }
        const char* nA = GATHER ? cA : (has_next ? (const char*)g.A + (size_t)nxt.pm * tstep : cA); const char* nB = has_next ? (const char*)g.Bt + (size_t)nxt.pn * tstep : cB;
        for (int t = 0; t < nt; t += 2) {
            const bool last = (t == nt - 2);
            if constexpr (DEP) { if (last && has_next && peek < g.need) PG8_WAIT_READY(nxt.pm); }
            const char* a1 = cA + (size_t)(t + 1) * kstep;
            const char* a2 = last ? nA : cA + (size_t)(t + 2) * kstep; const char* b2 = last ? nB : cB + (size_t)(t + 2) * kstep;
            const char* a3 = a2 + kstep; const char* b3 = b2 + kstep;
            unsigned vg2[2][2];
            if constexpr (GATHER) {
#pragma unroll
                for (int h = 0; h < 2; ++h)
#pragma unroll
                    for (int i = 0; i < 2; ++i) vg2[h][i] = last ? vgN[h][i] : vgC[h][i];
            }
            PG8_LDB(B0, 0, 0); PG8_LDB(B1, 0, 1); PG8_SCHED; PG8_LDA(At, 0, 0); PG8_STAGE_A(PG8_SA(1, 1), a1, 1, vgC);
            PG8_WAIT_V(8); PG8_WAIT_L(0); PG8_BAR; PG8_MMA(0, 0, At, B0); PG8_MMA(0, 1, At, B1); PG8_BAR; PG8_SCHED;
            PG8_LDA(At, 0, 1); PG8_STAGE(PG8_SB(0, 0), b2, voffB); PG8_STAGE(PG8_SB(0, 1), b2 + hstep, voffB); PG8_STAGE_A(PG8_SA(0, 0), a2, 0, vg2);
            PG8_WAIT_V(8); PG8_WAIT_L(0); PG8_BAR; PG8_MMA(1, 0, At, B0); PG8_MMA(1, 1, At, B1); PG8_BAR; PG8_SCHED;
            PG8_LDB(B0, 1, 0); PG8_LDB(B1, 1, 1); PG8_SCHED; PG8_LDA(At, 1, 0); PG8_STAGE_A(PG8_SA(0, 1), a2, 1, vg2);
            PG8_WAIT_V(8); PG8_WAIT_L(0); PG8_BAR; PG8_MMA(0, 0, At, B0); PG8_MMA(0, 1, At, B1); PG8_BAR; PG8_SCHED;
            PG8_LDA(At, 1, 1); PG8_STAGE(PG8_SB(1, 0), b3, voffB); PG8_STAGE(PG8_SB(1, 1), b3 + hstep, voffB); PG8_STAGE_A(PG8_SA(1, 0), a3, 0, vg2);
            PG8_WAIT_V(8); PG8_WAIT_L(0); PG8_BAR; PG8_MMA(1, 0, At, B0); PG8_MMA(1, 1, At, B1); PG8_BAR; PG8_SCHED;
        }
        if constexpr (ALIGN_EPI) { if (wr == 0) PG8_BAR; }
        const unsigned long long te0_ = g.tprobe ? __builtin_amdgcn_s_memrealtime() : 0ull;
        if constexpr (FP8) asm volatile("s_nop 15\n\ts_nop 15" ::: "memory");
        E(acc, cur, wr, wc, fr, fq);
        if (g.tprobe) { asm volatile("s_waitcnt vmcnt(0)" ::: "memory"); epi_t_ += __builtin_amdgcn_s_memrealtime() - te0_; }
        if (!has_next) break;
#pragma unroll
        for (int a = 0; a < 2; ++a)
#pragma unroll
            for (int b = 0; b < 2; ++b)
#pragma unroll
                for (int m = 0; m < 4; ++m)
#pragma unroll
                    for (int n = 0; n < 2; ++n) acc[a][b][m][n] = (f32x4){0.f, 0.f, 0.f, 0.f};
        cur = nxt; cA = nA; cB = nB; ++ui;
        if constexpr (GATHER) {
#pragma unroll
            for (int h = 0; h < 2; ++h)
#pragma unroll
                for (int i = 0; i < 2; ++i) vgC[h][i] = vgN[h][i];
        }
        if constexpr (ALIGN_EPI) { if (wr == 1) PG8_BAR; }
    }
    PG8_WAIT_V(0);
    if constexpr (!ALIGN_EPI) { if (wr == 0) PG8_BAR; }
    PG8_BAR;
    if (g.tprobe && threadIdx.x == 0) *g.tprobe = epi_t_;
#undef PG8_PEEK
#undef PG8_WAIT_READY
#undef PG8_SA
#undef PG8_SB
#undef PG8_STAGE
#undef PG8_STAGE_A
#undef PG8_LDA
#undef PG8_LD8
#undef PG8_LDB
#undef PG8_MMA
#undef PG8_WAIT_V
#undef PG8_WAIT_L
#undef PG8_BAR
#undef PG8_SCHED
}
}
namespace attn_body {
using bf16=__hip_bfloat16;
using bf16x8=__attribute__((ext_vector_type(8)))short;
using s16x4=__attribute__((ext_vector_type(4)))short;
using f32x16=__attribute__((ext_vector_type(16)))float;
using u32x4=__attribute__((ext_vector_type(4)))unsigned;
typedef float f32x4_t __attribute__((ext_vector_type(4)));
constexpr int BATCH=8,NHEAD=8,SEQ=2048,D=64,DM=NHEAD*D,OPITCH=1024;
constexpr int NW=8,QBLK=32,QB=QBLK*NW,KVBLK=64,NQB=SEQ/QB;
static_assert(NQB==8,"static order assumes 8 query blocks per (b,h)");
__device__ __forceinline__ int crow(int r,int hi){return (r&3)+8*(r>>2)+4*hi;}
#define SBAR() __builtin_amdgcn_sched_barrier(0)
__device__ __forceinline__ void cmask(f32x16&p0,f32x16&p1,int jb,int qrel,int hi){
  const float NEG=-INFINITY; int kb=64*jb+4*hi;
  #pragma unroll
  for(int r=0;r<16;++r){int kv=kb+(r&3)+8*(r>>2); if(kv>qrel)p0[r]=NEG; if(kv+32>qrel)p1[r]=NEG;}
}

constexpr int NSLOT=3, SLOTB=8192;
constexpr int LDS_K=0, LDS_V=NSLOT*SLOTB, LDS_WS=2*NSLOT*SLOTB, LDS_OST=LDS_WS+NW*64*4, LDS_KB=LDS_OST+NW*4096, LDS_BYTES=LDS_KB+SEQ*4;
constexpr float C2=0.125f*1.4426950408889634f;
__device__ __forceinline__ void glds16(const void*gsrc,unsigned lds_dst){unsigned keep;
  asm volatile("s_mov_b32 %0, m0\n\ts_mov_b32 m0, %2\n\ts_nop 0\n\tglobal_load_lds_dwordx4 %1, off\n\ts_mov_b32 m0, %0":"=&s"(keep):"v"(gsrc),"s"(lds_dst):"memory");}
__device__ __forceinline__ float max3f(float a,float b,float c){float r;asm("v_max3_f32 %0, %1, %2, %3":"=v"(r):"v"(a),"v"(b),"v"(c));return r;}
__device__ __forceinline__ float max2f(float a,float b){float r;asm("v_max_f32_e32 %0, %1, %2":"=v"(r):"v"(a),"v"(b));return r;}
__device__ __forceinline__ float fadd_s(float a,float b){float r;asm("v_add_f32_e32 %0, %1, %2":"=v"(r):"v"(a),"v"(b));return r;}
__device__ __forceinline__ float fsub_s(float a,float b){float r;asm("v_sub_f32_e32 %0, %1, %2":"=v"(r):"v"(a),"v"(b));return r;}
typedef float f32x2_t __attribute__((ext_vector_type(2))); typedef __bf16 bf16x2_t __attribute__((ext_vector_type(2)));
__device__ __forceinline__ unsigned cvtpk_s(float lo,float hi){f32x2_t v={lo,hi};bf16x2_t b=__builtin_convertvector(v,bf16x2_t);return __builtin_bit_cast(unsigned,b);}
#define WAIT_BAR(N) asm volatile("s_waitcnt vmcnt(" #N ") lgkmcnt(0)\n\ts_barrier":::"memory")

__device__ __forceinline__ void qkt(f32x16&p0,f32x16&p1,const char*Kslot,const bf16x8*qr,int r32,int hi){
  const char*kb=Kslot+hi*1024+r32*16;
  #pragma unroll
  for(int d0=0;d0<4;++d0){
    const bf16x8 b0=*reinterpret_cast<const bf16x8*>(kb+d0*2048);
    const bf16x8 b1=*reinterpret_cast<const bf16x8*>(kb+d0*2048+512);
    {p0=__builtin_amdgcn_mfma_f32_32x32x16_bf16(b0,qr[d0],p0,0,0,0);p1=__builtin_amdgcn_mfma_f32_32x32x16_bf16(b1,qr[d0],p1,0,0,0);}}
}
typedef __attribute__((address_space(3))) const char* lds_cptr;
typedef short v4i16_t __attribute__((ext_vector_type(4)));
__device__ __forceinline__ void kload8(bf16x8*kf,lds_cptr kp){
  kf[0]=*(const __attribute__((address_space(3))) bf16x8*)(kp);      kf[1]=*(const __attribute__((address_space(3))) bf16x8*)(kp+512);
  kf[2]=*(const __attribute__((address_space(3))) bf16x8*)(kp+2048); kf[3]=*(const __attribute__((address_space(3))) bf16x8*)(kp+2560);
  kf[4]=*(const __attribute__((address_space(3))) bf16x8*)(kp+4096); kf[5]=*(const __attribute__((address_space(3))) bf16x8*)(kp+4608);
  kf[6]=*(const __attribute__((address_space(3))) bf16x8*)(kp+6144); kf[7]=*(const __attribute__((address_space(3))) bf16x8*)(kp+6656);
}
__device__ __forceinline__ void kload2(bf16x8*kf,lds_cptr kp,int j){ kf[2*j]=*(const __attribute__((address_space(3))) bf16x8*)(kp+j*2048); kf[2*j+1]=*(const __attribute__((address_space(3))) bf16x8*)(kp+j*2048+512); }
__device__ __forceinline__ s16x4 vtr(lds_cptr p){ return __builtin_bit_cast(s16x4,__builtin_amdgcn_ds_read_tr16_b64_v4i16((__attribute__((address_space(3))) v4i16_t*)p)); }
__device__ __forceinline__ float rowmax(const f32x16&p0,const f32x16&p1){
  float a=max3f(p0[0],p0[1],p1[0]),b=max3f(p0[2],p0[3],p1[1]);a=max3f(a,p1[2],p1[3]);
  #pragma unroll
  for(int r=4;r<16;r+=4){a=max3f(a,p0[r],p0[r+1]);b=max3f(b,p0[r+2],p0[r+3]);a=max3f(a,p1[r],p1[r+1]);b=max3f(b,p1[r+2],p1[r+3]);}
  const float m=max2f(a,b);
  auto rr=__builtin_amdgcn_permlane32_swap(__float_as_uint(m),__float_as_uint(m),false,false);
  return max2f(__uint_as_float(rr[0]),__uint_as_float(rr[1]));
}
__device__ __forceinline__ void pv(f32x16*o,int vb,bf16x8 pa0,bf16x8 pa1,bf16x8 pa2,bf16x8 pa3){
  #pragma unroll
  for(int d0=0;d0<2;++d0){s16x4 lo[4],hi[4];
    #pragma unroll
    for(int ks=0;ks<4;++ks){
      asm volatile("ds_read_b64_tr_b16 %0,%1 offset:%c2":"=&v"(lo[ks]):"v"(vb),"i"(d0*4096+ks*1024):"memory");
      asm volatile("ds_read_b64_tr_b16 %0,%1 offset:%c2":"=&v"(hi[ks]):"v"(vb),"i"(d0*4096+ks*1024+512):"memory");}
    asm volatile("s_waitcnt lgkmcnt(0)":::"memory");SBAR();
    #define PK(k) (bf16x8){lo[k][0],lo[k][1],lo[k][2],lo[k][3],hi[k][0],hi[k][1],hi[k][2],hi[k][3]}
    o[d0]=__builtin_amdgcn_mfma_f32_32x32x16_bf16(pa0,PK(0),o[d0],0,0,0);
    o[d0]=__builtin_amdgcn_mfma_f32_32x32x16_bf16(pa1,PK(1),o[d0],0,0,0);
    o[d0]=__builtin_amdgcn_mfma_f32_32x32x16_bf16(pa2,PK(2),o[d0],0,0,0);
    o[d0]=__builtin_amdgcn_mfma_f32_32x32x16_bf16(pa3,PK(3),o[d0],0,0,0);
    #undef PK
  }
}

#ifndef ATTN_STORE16
#define ATTN_STORE16(p,v) (*(u32x4*)(p)=(v))
#endif
template<int THRL> __device__ __forceinline__ void attn_unit(int b,int h,int qb,const bf16*Q,const bf16*__restrict__ K,const bf16*__restrict__ V,bf16*O,const float*kbias,const float*onw,char*shm){
  const int tid=threadIdx.x,lane=tid&63,r32=lane&31,hi=lane>>5; const int wid=__builtin_amdgcn_readfirstlane(tid>>6);
  const long rowbase=(long)b*SEQ; const int q0=qb*QB;
  const bf16*Qw=Q+(rowbase+q0+wid*QBLK)*DM+h*D;
  const bf16*Kh=K+rowbase*DM+h*D,*Vh=V+rowbase*DM+h*D;
  const unsigned lds0=(unsigned)(uintptr_t)shm;
  float*wsf=(float*)(shm+LDS_WS)+wid*64;
  const bf16*ksrc=Kh+(long)lane*DM+wid*8;
  const bf16*vsrc=Vh+(long)(16*(wid&3)+(lane>>2))*DM+(wid>>2)*32+(lane&3)*8;
  const unsigned kdst=lds0+LDS_K+wid*1024, vdst=lds0+LDS_V+wid*1024;
  #define DMA_K(t,slot) glds16(ksrc+(long)(t)*KVBLK*DM,(unsigned)__builtin_amdgcn_readfirstlane(kdst+(slot)))
  #define DMA_V(t,slot) glds16(vsrc+(long)(t)*KVBLK*DM,(unsigned)__builtin_amdgcn_readfirstlane(vdst+(slot)))
  const int vb0=(int)(lds0+LDS_V)+((lane>>4)&1)*32+(lane&3)*8+(4*hi+((lane&15)>>2))*64;
  const char*Kbase=shm+LDS_K; bf16x8 kf[8];
  const lds_cptr shm3=(lds_cptr)shm; const lds_cptr kp0=shm3+LDS_K+hi*1024+r32*16; const lds_cptr vp0=shm3+LDS_V+((lane>>4)&1)*32+(lane&3)*8+(4*hi+((lane&15)>>2))*64;
  const int NT=(q0+QB)/KVBLK;
  { const float*kbg=kbias+(long)(b*NHEAD+h)*SEQ;
    if(tid*4<NT*KVBLK){ const f32x4_t kv4=*(const f32x4_t*)(kbg+tid*4); *(__attribute__((address_space(3))) f32x4_t*)(shm3+LDS_KB+tid*16)=kv4; } }
  DMA_K(0,0);DMA_V(0,0);DMA_K(1,SLOTB);
  bf16x8 qr[4];
  #pragma unroll
  for(int d0=0;d0<4;++d0)qr[d0]=*reinterpret_cast<const bf16x8*>(&Qw[(long)r32*DM+d0*16+hi*8]);
  float mhat=0.f,l_reg=0.f;f32x16 o[2];o[0]=f32x16{};o[1]=f32x16{};
  const int qrel=wid*QBLK+r32;
  #define CMASK(P0,P1,t) do{int jb_=(t)-(NT-4); if(jb_>=0)cmask(P0,P1,jb_,qrel,hi);}while(0)
  #define KBIAS(P0,P1,t) do{ const lds_cptr kb_=shm3+LDS_KB+(t)*256+hi*16; _Pragma("unroll") for(int g_=0;g_<4;++g_){ \
      const f32x4_t a_=*(const __attribute__((address_space(3))) f32x4_t*)(kb_+g_*32), b_=*(const __attribute__((address_space(3))) f32x4_t*)(kb_+g_*32+128); \
      P0[4*g_]=a_[0]-mhat;P0[4*g_+1]=a_[1]-mhat;P0[4*g_+2]=a_[2]-mhat;P0[4*g_+3]=a_[3]-mhat; P1[4*g_]=b_[0]-mhat;P1[4*g_+1]=b_[1]-mhat;P1[4*g_+2]=b_[2]-mhat;P1[4*g_+3]=b_[3]-mhat; \
      if(g_&1){asm volatile("":::"memory");} } }while(0)
  bool resc=false;
  #define START(P0,P1) do{ const float rm=rowmax(P0,P1); resc=false; \
    { const float dl=rm; mhat=fadd_s(mhat,dl); \
      _Pragma("unroll") for(int r=0;r<16;++r){P0[r]=fsub_s(P0[r],dl);P1[r]=fsub_s(P1[r],dl);} \
      } \
    _Pragma("unroll") for(int r=0;r<16;++r)P0[r]=__builtin_amdgcn_exp2f(P0[r]); }while(0)
  #define RESC() do{ if(resc){ asm volatile("s_waitcnt lgkmcnt(0)":::"memory"); \
      _Pragma("unroll") for(int d_=0;d_<2;++d_) _Pragma("unroll") for(int r=0;r<16;++r)o[d_][r]*=wsf[crow(r,hi)]; } }while(0)
  f32x16 pA0,pA1,pB0,pB1;
  int sl_prev=0,sl_cur=0,sl_next=SLOTB;
  #define ROT() do{sl_prev=sl_cur;sl_cur=sl_next;sl_next=(sl_next==(NSLOT-1)*SLOTB)?0:sl_next+SLOTB;}while(0)
  DMA_K(2,2*SLOTB);
  WAIT_BAR(3);
  KBIAS(pA0,pA1,0); qkt(pA0,pA1,Kbase,qr,r32,hi);asm volatile("s_nop 15\n\ts_nop 7":"+v"(pA0),"+v"(pA1));CMASK(pA0,pA1,0);
  START(pA0,pA1);
  _Pragma("unroll") for(int r=0;r<16;++r)pA1[r]=__builtin_amdgcn_exp2f(pA1[r]);
  WAIT_BAR(0);
  DMA_K(3,0);DMA_V(1,SLOTB);
  ROT();
  kload8(kf,kp0+sl_cur);
  WAIT_BAR(2);
  s16x4 vlo[8],vhi[8]; u32x4 pw0,pw1,pw2,pw3;
  #define PKW(P,B) cvtpk_s(P[B],P[B+1])
  #define PAF(k) __builtin_bit_cast(bf16x8,pw##k)
  #define VFR(i) (bf16x8){vlo[i][0],vlo[i][1],vlo[i][2],vlo[i][3],vhi[i][0],vhi[i][1],vhi[i][2],vhi[i][3]}
  #define PIN(x) asm volatile("":"+v"(x))
  #define MX3(a,b,c) __builtin_fmaxf(__builtin_fmaxf((a),(b)),(c))
  #define GAPA(MF,A0,A1,A2,A3,W0,W1,PW) do{ MF; sacc+=A0; sacc+=A1; sacc+=A2; sacc+=A3; PIN(sacc); W0; W1; PIN(PW); SBAR(); }while(0)
  #define EX(v) __builtin_amdgcn_exp2f(v)
  #define GAPB(MF,X,B) do{ MF; X[B]=EX(X[B]); X[B+1]=EX(X[B+1]); X[B+2]=EX(X[B+2]); X[B+3]=EX(X[B+3]); PIN(X); SBAR(); }while(0)
  #define VRD(i) do{ vlo[i]=vtr(vp_+(((i)>>2)*4096+((i)&3)*1024)); vhi[i]=vtr(vp_+(((i)>>2)*4096+((i)&3)*1024+512)); }while(0)
  #define KRD(G,j) do{ if(G){ kload2(kf,kp0+sl_next,j); SBAR(); } }while(0)
  #define STEP(C0,C1,P0,P1,t,GK,GV,GL) do{ SBAR(); KBIAS(C0,C1,t); \
    const lds_cptr vp_=vp0+sl_prev; \
    VRD(0); SBAR(); float sacc=(P0[0]+P0[1]); \
    GAPA(C0=__builtin_amdgcn_mfma_f32_32x32x16_bf16(kf[0],qr[0],C0,0,0,0), P0[2],P0[3],P0[4],P0[5],     pw0[0]=PKW(P0,0), pw0[1]=PKW(P0,2), pw0); \
    VRD(4); SBAR(); GAPA(C1=__builtin_amdgcn_mfma_f32_32x32x16_bf16(kf[1],qr[0],C1,0,0,0), P0[6],P0[7],P0[8],P0[9],     pw0[2]=PKW(P0,4), pw0[3]=PKW(P0,6), pw0); \
    VRD(1); SBAR(); GAPA(C0=__builtin_amdgcn_mfma_f32_32x32x16_bf16(kf[2],qr[1],C0,0,0,0),   P0[10],P0[11],P0[12],P0[13], pw1[0]=PKW(P0,8), pw1[1]=PKW(P0,10), pw1); \
    VRD(5); SBAR(); GAPA(C1=__builtin_amdgcn_mfma_f32_32x32x16_bf16(kf[3],qr[1],C1,0,0,0),   P0[14],P0[15],P1[0],P1[1],   pw1[2]=PKW(P0,12),pw1[3]=PKW(P0,14), pw1); \
    VRD(2); SBAR(); GAPA(C0=__builtin_amdgcn_mfma_f32_32x32x16_bf16(kf[4],qr[2],C0,0,0,0),   P1[2],P1[3],P1[4],P1[5],     pw2[0]=PKW(P1,0), pw2[1]=PKW(P1,2), pw2); \
    VRD(6); SBAR(); GAPA(C1=__builtin_amdgcn_mfma_f32_32x32x16_bf16(kf[5],qr[2],C1,0,0,0),   P1[6],P1[7],P1[8],P1[9],     pw2[2]=PKW(P1,4), pw2[3]=PKW(P1,6), pw2); \
    VRD(3); SBAR(); GAPA(C0=__builtin_amdgcn_mfma_f32_32x32x16_bf16(kf[6],qr[3],C0,0,0,0),   P1[10],P1[11],P1[12],P1[13], pw3[0]=PKW(P1,8), pw3[1]=PKW(P1,10), pw3); \
    VRD(7); SBAR(); GAPA(C1=__builtin_amdgcn_mfma_f32_32x32x16_bf16(kf[7],qr[3],C1,0,0,0),   P1[14],P1[15],0.f,0.f,       pw3[2]=PKW(P1,12),pw3[3]=PKW(P1,14), pw3); \
    l_reg+=sacc; \
    if(GK){DMA_K((t)+3,sl_cur);} if(GV){DMA_V((t)+1,sl_next);} \
    CMASK(C0,C1,t); \
    { float a=MX3(C0[0],C0[1],C1[0]),b=MX3(C0[2],C0[3],C1[1]); a=MX3(a,C1[2],C1[3]); \
      _Pragma("unroll") for(int r=4;r<16;r+=4){a=MX3(a,C0[r],C0[r+1]);b=MX3(b,C0[r+2],C0[r+3]);a=MX3(a,C1[r],C1[r+1]);b=MX3(b,C1[r+2],C1[r+3]);} \
      float rm=__builtin_fmaxf(a,b); { auto rr=__builtin_amdgcn_permlane32_swap(__float_as_uint(rm),__float_as_uint(rm),false,false); rm=__builtin_fmaxf(__uint_as_float(rr[0]),__uint_as_float(rr[1])); } \
      resc=false; \
      if(__builtin_expect(__any(rm>(float)THRL),0)){ const float dl=__builtin_fmaxf(rm,0.f); mhat+=dl; \
        _Pragma("unroll") for(int r=0;r<16;++r){C0[r]-=dl;C1[r]-=dl;} \
        const float f=__builtin_amdgcn_exp2f(-dl); l_reg*=f; if(hi==0)wsf[r32]=f; resc=true; } } \
    SBAR(); \
    GAPB(o[0]=__builtin_amdgcn_mfma_f32_32x32x16_bf16(PAF(0),VFR(0),o[0],0,0,0), C0,0); \
    GAPB(o[1]=__builtin_amdgcn_mfma_f32_32x32x16_bf16(PAF(0),VFR(4),o[1],0,0,0), C0,4); \
    KRD(GL,0); GAPB(o[0]=__builtin_amdgcn_mfma_f32_32x32x16_bf16(PAF(1),VFR(1),o[0],0,0,0), C0,8); \
    KRD(GL,1); GAPB(o[1]=__builtin_amdgcn_mfma_f32_32x32x16_bf16(PAF(1),VFR(5),o[1],0,0,0), C0,12); \
    KRD(GL,2); GAPB(o[0]=__builtin_amdgcn_mfma_f32_32x32x16_bf16(PAF(2),VFR(2),o[0],0,0,0), C1,0); \
    KRD(GL,3); GAPB(o[1]=__builtin_amdgcn_mfma_f32_32x32x16_bf16(PAF(2),VFR(6),o[1],0,0,0), C1,4); \
    GAPB(o[0]=__builtin_amdgcn_mfma_f32_32x32x16_bf16(PAF(3),VFR(3),o[0],0,0,0), C1,8); \
    GAPB(o[1]=__builtin_amdgcn_mfma_f32_32x32x16_bf16(PAF(3),VFR(7),o[1],0,0,0), C1,12); \
    }while(0)
  int t=1;
  #undef CMASK
  #define CMASK(P0,P1,t) do{}while(0)
  for(;t+5<NT;t+=2){
    STEP(pB0,pB1,pA0,pA1,t,true,true,true);     WAIT_BAR(2); RESC(); ROT();
    STEP(pA0,pA1,pB0,pB1,t+1,true,true,true);   WAIT_BAR(2); RESC(); ROT();
  }
  #undef CMASK
  #define CMASK(P0,P1,t) do{int jb_=(t)-(NT-4); if(jb_>=0)cmask(P0,P1,jb_,qrel,hi);}while(0)
  #define ENDW(tt) do{ if((tt)+3<NT){WAIT_BAR(2);} else if((tt)+2<NT){WAIT_BAR(1);} else {WAIT_BAR(0);} }while(0)
  for(;t+1<NT;t+=2){
    STEP(pB0,pB1,pA0,pA1,t,(t+3<NT),(t+1<NT),(t+1<NT));       ENDW(t);   RESC(); ROT();
    STEP(pA0,pA1,pB0,pB1,t+1,(t+4<NT),(t+2<NT),(t+2<NT));     ENDW(t+1); RESC(); ROT();
  }
  STEP(pB0,pB1,pA0,pA1,NT-1,false,false,false); RESC();
  { float sacc=pB0[0]+pB0[1]; _Pragma("unroll") for(int r=2;r<16;++r)sacc+=pB0[r]; _Pragma("unroll") for(int r=0;r<16;++r)sacc+=pB1[r]; l_reg+=sacc;
    pw0=(u32x4){PKW(pB0,0),PKW(pB0,2),PKW(pB0,4),PKW(pB0,6)};pw1=(u32x4){PKW(pB0,8),PKW(pB0,10),PKW(pB0,12),PKW(pB0,14)};pw2=(u32x4){PKW(pB1,0),PKW(pB1,2),PKW(pB1,4),PKW(pB1,6)};pw3=(u32x4){PKW(pB1,8),PKW(pB1,10),PKW(pB1,12),PKW(pB1,14)};
    SBAR(); pv(o,vb0+sl_cur,PAF(0),PAF(1),PAF(2),PAF(3)); }
  #undef PKW
  #undef PAF
  #undef VFR
  #undef PIN
  #undef MX3
  #undef GAPA
  #undef GAPB
  #undef EX
  #undef VRD
  #undef KRD
  #undef STEP
  #undef ENDW
  {auto rr=__builtin_amdgcn_permlane32_swap(__float_as_uint(l_reg),__float_as_uint(l_reg),false,false);l_reg=__uint_as_float(rr[0])+__uint_as_float(rr[1]);}
  if(hi==0)wsf[32+r32]=l_reg;asm volatile("s_waitcnt lgkmcnt(0)":::"memory");
  float rli[16];
  #pragma unroll
  for(int r=0;r<16;++r)rli[r]=__builtin_amdgcn_rcpf(wsf[32+crow(r,hi)]);
  bf16*Ow=O+(rowbase+q0+wid*QBLK)*OPITCH+h*D;
  { bf16*stg=(bf16*)(shm+LDS_OST)+wid*2048;
    #pragma unroll
    for(int r=0;r<16;++r){const int orow=crow(r,hi);
      #pragma unroll
      for(int d0=0;d0<2;++d0)stg[orow*64+d0*32+r32]=__float2bfloat16(o[d0][r]*rli[r]);}
    asm volatile("s_waitcnt lgkmcnt(0)":::"memory");
    #pragma unroll
    for(int i=0;i<4;++i){const int row=i*8+(lane>>3),ch=lane&7; const u32x4 v=*(const u32x4*)(stg+row*64+ch*8);
      float x[8]; _Pragma("unroll") for(int j=0;j<4;++j){x[2*j]=__uint_as_float(v[j]<<16);x[2*j+1]=__uint_as_float(v[j]&0xffff0000u);}
      float ss=0.f; _Pragma("unroll") for(int j=0;j<8;++j)ss+=x[j]*x[j];
      ss+=__shfl_xor(ss,1);ss+=__shfl_xor(ss,2);ss+=__shfl_xor(ss,4);
      const float rs=__builtin_amdgcn_rsqf(ss*(1.0f/64.0f)+1e-5f); const f32x4_t w0=*(const f32x4_t*)(onw+h*D+ch*8),w1=*(const f32x4_t*)(onw+h*D+ch*8+4);
      u32x4 ov; ov[0]=cvtpk_s(x[0]*rs*w0[0],x[1]*rs*w0[1]);ov[1]=cvtpk_s(x[2]*rs*w0[2],x[3]*rs*w0[3]);ov[2]=cvtpk_s(x[4]*rs*w1[0],x[5]*rs*w1[1]);ov[3]=cvtpk_s(x[6]*rs*w1[2],x[7]*rs*w1[3]);
      ATTN_STORE16(Ow+(long)row*OPITCH+ch*8,ov);} }
  asm volatile("s_waitcnt lgkmcnt(0)\n\ts_barrier":::"memory");
  #undef DMA_K
  #undef DMA_V
  #undef CMASK
  #undef KBIAS
  #undef START
  #undef RESC
  #undef ROT
}
constexpr int ATTN_LDS_BYTES=LDS_BYTES;
struct AttnTensors { const bf16* Q; const bf16* K; const bf16* V; bf16* O; const float* kbias; const float* onw; };
struct AttnUnit { int bh; int qb; };
struct StaticOrder {
  int vcu,G;
  __device__ __forceinline__ StaticOrder(int grid,int vcu_):vcu(vcu_),G(grid){}
  __device__ __forceinline__ bool next(int i,AttnUnit&u)const{ const int pi=vcu+G*(i>>1); if(pi>=BATCH*NHEAD*(NQB/2))return false; const int s=pi&3; u.bh=pi>>2; u.qb=(i&1)?(NQB-1-s):s; return true; }
};
template<class Sched,int THRL=64> __device__ __forceinline__ void attn_phase(char*lds,const AttnTensors&T,const Sched&S){
  AttnUnit u;
  for(int i=0;S.next(i,u);++i){ attn_unit<THRL>(u.bh/NHEAD,u.bh%NHEAD,u.qb,T.Q,T.K,T.V,T.O,T.kbias,T.onw,lds); }
}
#undef SBAR
#undef WAIT_BAR
}

constexpr int NWAVES = 8;
#ifndef MK_N_LAUNCHES
#define MK_N_LAUNCHES 1
#endif
constexpr int N_PHASES = 10;
constexpr int N_LAUNCHES = MK_N_LAUNCHES;

constexpr size_t MiB = 1u << 20;
constexpr size_t WS_CTL = 0, CTL_ZERO_BYTES = 160 * 1024;
constexpr size_t WS_WIN = 2 * MiB;
constexpr size_t WS_WOUT = 8 * MiB;
constexpr size_t WS_WGU = 10 * MiB;
constexpr size_t WS_WD = 138 * MiB;
constexpr size_t WS_XN = 202 * MiB;
constexpr size_t WS_T6 = 234 * MiB, T6_STRIDE = 16 * MiB;
constexpr size_t WS_MIX = 330 * MiB;
constexpr size_t WS_GATES = 362 * MiB;
constexpr size_t WS_KBIAS = 364 * MiB;
constexpr size_t WS_MST = 365 * MiB;
constexpr size_t WS_ROUTE = 383 * MiB;
constexpr size_t WS_X1B = 480 * MiB;
constexpr size_t WS_MPS = 460 * MiB;
constexpr size_t WS_ACT = 386 * MiB;
constexpr size_t WS_Y = 530 * MiB;
constexpr size_t WS_END = 674 * MiB;
constexpr int MST_PITCH = 2048 + 64;
constexpr size_t RT_TOPI = 0, RT_TOPW = 256 * 1024, RT_HIST = 512 * 1024, RT_POSSLOT = 1024 * 1024, RT_TOKPOS = 1280 * 1024, RT_GATEPOS = 1600 * 1024, RT_TILEPREF = 2048 * 1024;
constexpr int NSEG = MTOK / 64;
static_assert(WS_ACT + (size_t)MAXPOS * DE * 2 <= WS_Y && WS_Y + (size_t)MAXPOS * DMODEL * 2 <= WS_END && WS_MST + (size_t)2048 * MST_PITCH * 4 <= WS_ROUTE, "d_ws map");
constexpr int CW_BAR = 4096;
constexpr int CW_MOE = 16384;

constexpr int RING_BYTES = 143360;
constexpr int LDSCTL_OFF = RING_BYTES, MISC_OFF = LDSCTL_OFF + 320;
constexpr int LDS_BYTES = 147456;

#define GAS __attribute__((address_space(1)))
#define LAS __attribute__((address_space(3)))
typedef unsigned short bf16;
typedef unsigned v4u __attribute__((ext_vector_type(4)));
typedef float f32x4 __attribute__((ext_vector_type(4)));
typedef short bf16x8 __attribute__((ext_vector_type(8)));
typedef GAS unsigned gu32;
typedef GAS unsigned long long gu64;
#define RLX_AGENT __ATOMIC_RELAXED, __HIP_MEMORY_SCOPE_AGENT
#define LDS_WAIT() asm volatile("s_waitcnt lgkmcnt(0)" ::: "memory")
#define VM_WAIT() asm volatile("s_waitcnt vmcnt(0)" ::: "memory")
__device__ __forceinline__ unsigned long long rt() { return __builtin_amdgcn_s_memrealtime(); }
__device__ __forceinline__ unsigned f2bf(float f) { return (unsigned)__builtin_bit_cast(unsigned short, (__bf16)f); }
typedef float f32x2_pk __attribute__((ext_vector_type(2))); typedef __bf16 bf16x2_pk __attribute__((ext_vector_type(2)));
__device__ __forceinline__ unsigned pk2(float lo, float hi) { const f32x2_pk v = {lo, hi}; return __builtin_bit_cast(unsigned, __builtin_convertvector(v, bf16x2_pk)); }

#define XB_TMO      128
#define XB_XCNT(j)  (256  + 64 * (j))
#define XB_XSUB(j)  (1280 + 64 * (j))
#define XB_XGEN(j)  (2304 + 64 * (j))
#define XB_TOP      3328
#define XB_TOPGEN   3392
#define XCD_BAR_WORDS 3456
#define XB_SPIN_CAP (1u << 18)

__device__ __forceinline__ unsigned xb_ld(unsigned* p)              { return __hip_atomic_load(p, __ATOMIC_RELAXED, __HIP_MEMORY_SCOPE_AGENT); }
__device__ __forceinline__ unsigned xb_add(unsigned* p, unsigned v) { return __hip_atomic_fetch_add(p, v, __ATOMIC_RELAXED, __HIP_MEMORY_SCOPE_AGENT); }
__device__ __forceinline__ unsigned xb_xcc_id() { return (unsigned)__builtin_amdgcn_s_getreg((3 << 11) | 20) & 0xFu; }
#define XB_SPIN(cond, bar) do { unsigned _sp = 0; while (cond) { __builtin_amdgcn_s_sleep(1); \
    if ((++_sp & 255u) == 0u) { if (xb_ld(&(bar)[XB_TMO])) break; if (_sp > XB_SPIN_CAP) { atomicAdd(&(bar)[XB_TMO], 1u); break; } } } } while (0)

struct XcdBarrier {
    unsigned* bar; unsigned x;
    volatile LAS unsigned* st;
};

__device__ __forceinline__ XcdBarrier xcd_barrier_post(unsigned* bar, volatile LAS unsigned* st) {
    XcdBarrier b; b.bar = bar; b.x = xb_xcc_id(); b.st = st;
    if (threadIdx.x == 0) { const unsigned rank_ = xb_add(&bar[XB_XCNT(b.x)], 1u); st[2] = rank_; st[3] = b.x; }
    return b;
}
__device__ __forceinline__ void xcd_barrier_complete(unsigned* bar, unsigned x, unsigned& nloc, unsigned& nx) {
    const unsigned G = gridDim.x * gridDim.y * gridDim.z;
    unsigned sum, cnt, mine, sp = 0u;
    for (;;) {
        sum = 0u; cnt = 0u; mine = 0u;
#pragma unroll
        for (unsigned j = 0; j < 16; ++j) { const unsigned c = xb_ld(&bar[XB_XCNT(j)]); sum += c; cnt += (c > 0u) ? 1u : 0u; mine = (j == x) ? c : mine; }
        if (sum == G) break;
        __builtin_amdgcn_s_sleep(1);
        if ((++sp & 255u) == 0u) { if (xb_ld(&bar[XB_TMO])) break; if (sp > XB_SPIN_CAP) { atomicAdd(&bar[XB_TMO], 1u); break; } }
    }
    nloc = mine > 0u ? mine : 1u; nx = cnt > 0u ? cnt : 1u;
}

__device__ __forceinline__ void xcd_barrier(const XcdBarrier& b) {
    asm volatile("s_waitcnt vmcnt(0)" ::: "memory");
    __syncthreads();
    if (threadIdx.x == 0) {
        unsigned* bar = b.bar;
        __builtin_amdgcn_s_waitcnt(0);
        unsigned nloc = b.st[0], nx = b.st[1];
        if (nloc == 0u) { xcd_barrier_complete(bar, b.x, nloc, nx); b.st[0] = nloc; b.st[1] = nx; }
        const unsigned old = xb_add(&bar[XB_XSUB(b.x)], 1u);
        const unsigned gen = old / nloc;
        if (old + 1u == (gen + 1u) * nloc) {
            __builtin_amdgcn_fence(__ATOMIC_RELEASE, "agent");
            asm volatile("s_waitcnt vmcnt(0)" ::: "memory");
            const unsigned og = xb_add(&bar[XB_TOP], 1u);
            const unsigned tg = og / nx;
            if (og + 1u == (tg + 1u) * nx) xb_add(&bar[XB_TOPGEN], 1u);
            else XB_SPIN(xb_ld(&bar[XB_TOPGEN]) == tg, bar);
            __builtin_amdgcn_fence(__ATOMIC_ACQUIRE, "agent");
            xb_add(&bar[XB_XGEN(b.x)], 1u);
            asm volatile("s_waitcnt vmcnt(0)" ::: "memory");
        } else {
            XB_SPIN(xb_ld(&bar[XB_XGEN(b.x)]) == gen, bar);
            __builtin_amdgcn_fence(__ATOMIC_ACQUIRE, "agent");
            asm volatile("s_waitcnt vmcnt(0)" ::: "memory");
        }
    }
    __syncthreads();
}

__device__ __forceinline__ float bf2f(unsigned short x) { return __uint_as_float((unsigned)x << 16); }
__device__ __forceinline__ float bflo(unsigned w) { return __uint_as_float(w << 16); }
__device__ __forceinline__ float bfhi(unsigned w) { return __uint_as_float(w & 0xffff0000u); }
__device__ __forceinline__ float wave_sum(float v) {
#pragma unroll
    for (int o = 1; o < 64; o <<= 1) v += __shfl_xor(v, o);
    return v;
}
__device__ __forceinline__ float wave_max(float v) {
#pragma unroll
    for (int o = 1; o < 64; o <<= 1) v = fmaxf(v, __shfl_xor(v, o));
    return v;
}
__device__ __forceinline__ float wave_scan_sum(float v, int lane) {
#pragma unroll
    for (int o = 1; o < 64; o <<= 1) { const float t = __shfl_up(v, o); if (lane >= o) v += t; }
    return v;
}
__device__ __forceinline__ float wave_scan_max(float v, int lane) {
#pragma unroll
    for (int o = 1; o < 64; o <<= 1) { const float t = __shfl_up(v, o); if (lane >= o) v = fmaxf(v, t); }
    return v;
}
__device__ __forceinline__ float readlane_f(float v, int l) { return __uint_as_float(__builtin_amdgcn_readlane(__float_as_uint(v), l)); }
__device__ __forceinline__ float reduce32(const float (&v)[32], int lane) {
    float a[16], b[8], c[4], d[2];
#pragma unroll
    for (int e = 0; e < 16; ++e) { const float send = (lane & 32) ? v[e] : v[16 + e], keep = (lane & 32) ? v[16 + e] : v[e]; a[e] = keep + __shfl_xor(send, 32); }
#pragma unroll
    for (int e = 0; e < 8; ++e) { const float send = (lane & 16) ? a[e] : a[8 + e], keep = (lane & 16) ? a[8 + e] : a[e]; b[e] = keep + __shfl_xor(send, 16); }
#pragma unroll
    for (int e = 0; e < 4; ++e) { const float send = (lane & 8) ? b[e] : b[4 + e], keep = (lane & 8) ? b[4 + e] : b[e]; c[e] = keep + __shfl_xor(send, 8); }
#pragma unroll
    for (int e = 0; e < 2; ++e) { const float send = (lane & 4) ? c[e] : c[2 + e], keep = (lane & 4) ? c[2 + e] : c[e]; d[e] = keep + __shfl_xor(send, 4); }
    const float send = (lane & 2) ? d[0] : d[1], keep = (lane & 2) ? d[1] : d[0];
    float r = keep + __shfl_xor(send, 2);
    r += __shfl_xor(r, 1);
    return r;
}
__device__ __forceinline__ void fmac_s(float& c, float a, float b) { asm("v_fmac_f32_e32 %0, %1, %2" : "+v"(c) : "v"(a), "v"(b)); }
__device__ __forceinline__ float log_sigmoid(float z) { return fminf(z, 0.f) - log1pf(expf(-fabsf(z))); }

template <bool F8> __device__ __forceinline__ void p0_item(const float* src, int ldw, unsigned char* dst, LAS float* scr, int lane) {
    constexpr int KR = F8 ? 128 : 64;
#pragma unroll 8
    for (int i = 0; i < KR / 2; ++i) { const int kk = 2 * i + (lane >> 5); scr[kk * 33 + (lane & 31)] = src[(size_t)kk * ldw + (lane & 31)]; }
    LDS_WAIT(); asm volatile("" ::: "memory");
    if constexpr (!F8) {
        const int c = lane & 7;
#pragma unroll
        for (int j = 0; j < 4; ++j) { const int n = (lane >> 3) + 8 * j; const LAS float* s = scr + (8 * c) * 33 + n;
            v4u o; o.x = pk2(s[0 * 33], s[1 * 33]); o.y = pk2(s[2 * 33], s[3 * 33]); o.z = pk2(s[4 * 33], s[5 * 33]); o.w = pk2(s[6 * 33], s[7 * 33]);
            *(GAS v4u*)(dst + ((size_t)n * 1024 + 8 * c) * 2) = o; }
    } else {
        const int c = lane >> 3;
#pragma unroll
        for (int j = 0; j < 4; ++j) { const int n = (lane & 7) + 8 * j; const LAS float* s = scr + (16 * c) * 33 + n; v4u o;
#pragma unroll
            for (int q = 0; q < 4; ++q) { int pk = __builtin_amdgcn_cvt_pk_fp8_f32(s[(4 * q) * 33] * 32.0f, s[(4 * q + 1) * 33] * 32.0f, 0, false);
                pk = __builtin_amdgcn_cvt_pk_fp8_f32(s[(4 * q + 2) * 33] * 32.0f, s[(4 * q + 3) * 33] * 32.0f, pk, true); o[q] = (unsigned)pk; }
            *(GAS v4u*)(dst + (size_t)n * 1024 + 16 * c) = o; }
    }
    LDS_WAIT(); asm volatile("" ::: "memory");
}
struct P0Args { const float *x, *attn_norm_w, *w_in, *fox_f_bias, *mlstm_i_bias, *mlstm_f_bias, *w_out, *w_gu, *w_d; bf16 *WIN, *WOUT; unsigned char *WGU, *WD; bf16* XN; float* GATES; float* KB; };
__device__ __forceinline__ void p0_prologue(const P0Args& A, LAS unsigned char* lds, int vcu, int G, int tid, int lane, int wave) {
    LAS float* scr = (LAS float*)(lds + wave * 16896);
    const int gw = vcu * NWAVES + wave, NGW = G * NWAVES;
    constexpr int NI_IN = 16 * 96, NI_OUT = 16 * 32, NI_GU = NE * 8 * 64, NI_D = NE * 8 * 32, NITEMS = NI_IN + NI_OUT + NI_GU + NI_D;
    for (int it = gw; it < NITEMS; it += NGW) {
        int r = it;
        if (r < NI_IN) { const int kb = r / 96, nb = r % 96, drow = 32 * nb, pn = drow >> 8, p0 = drow & 255, cl = 256 * pn + 64 * ((p0 >> 5) & 3) + 32 * (p0 >> 7);
            const int src = cl + (cl < 1536 ? 0 : (cl < 2560 ? 8 : 24));
            p0_item<false>(A.w_in + (size_t)(64 * kb) * INW + src, INW, (unsigned char*)(A.WIN + (size_t)drow * 1024 + 64 * kb), scr, lane); continue; }
        r -= NI_IN;
        if (r < NI_OUT) { const int kb = r / 32, nb = r % 32;
            p0_item<false>(A.w_out + (size_t)(64 * kb) * DMODEL + 32 * nb, DMODEL, (unsigned char*)(A.WOUT + (size_t)(32 * nb) * 1024 + 64 * kb), scr, lane); continue; }
        r -= NI_OUT;
        if (r < NI_GU) { const int e = r / 512, q = r % 512, kb = q / 64, nb = q % 64, drow = 32 * nb, pn = drow >> 8, p0 = drow & 255;
            const int src = p0 < 128 ? 128 * pn + p0 : 1024 + 128 * pn + (p0 - 128);
            p0_item<true>(A.w_gu + (size_t)e * DMODEL * 2048 + (size_t)(128 * kb) * 2048 + src, 2048, A.WGU + ((size_t)e * 2048 + drow) * 1024 + 128 * kb, scr, lane); continue; }
        r -= NI_GU;
        { const int e = r / 256, q = r % 256, kb = q / 32, nb = q % 32;
            p0_item<true>(A.w_d + (size_t)e * DE * DMODEL + (size_t)(128 * kb) * DMODEL + 32 * nb, DMODEL, A.WD + ((size_t)e * 1024 + 32 * nb) * 1024 + 128 * kb, scr, lane); }
    }
    __syncthreads();
    LAS float* gwT = (LAS float*)lds;
    for (int idx = tid; idx < 3 * 1024 * 8; idx += NWAVES * 64) { const int c8 = idx & 7, k = (idx >> 3) & 1023, g3 = idx >> 13; const int base = g3 == 0 ? 1536 : (g3 == 1 ? 2568 : 2576);
        gwT[(8 * g3 + c8) * 1028 + k] = A.w_in[(size_t)k * INW + base + c8]; }
    __syncthreads();
    f32x4 wn[4];
#pragma unroll
    for (int j = 0; j < 4; ++j) wn[j] = *(const f32x4*)(A.attn_norm_w + 4 * lane + 256 * j);
    for (int m = gw; m < MTOK; m += NGW) {
        const GAS f32x4* xr = (const GAS f32x4*)(A.x + (size_t)m * DMODEL) + lane;
        f32x4 v[4]; float s = 0.f;
#pragma unroll
        for (int j = 0; j < 4; ++j) { v[j] = xr[64 * j]; s += (v[j].x * v[j].x + v[j].y * v[j].y) + (v[j].z * v[j].z + v[j].w * v[j].w); }
        const float rstd = 1.f / sqrtf(wave_sum(s) * (1.f / DMODEL) + NORM_EPS);
        GAS unsigned long long* o8 = (GAS unsigned long long*)(A.XN + (size_t)m * DMODEL) + lane;
#pragma unroll
        for (int j = 0; j < 4; ++j) { v[j] = v[j] * rstd * wn[j]; o8[64 * j] = (unsigned long long)pk2(v[j].x, v[j].y) | ((unsigned long long)pk2(v[j].z, v[j].w) << 32); }
        float p[32];
#pragma unroll
        for (int cg = 0; cg < 3; ++cg) {
#pragma unroll
            for (int cc = 0; cc < 8; ++cc) { const int c = cg * 8 + cc; float a = 0.f;
#pragma unroll
                for (int j = 0; j < 4; ++j) { const f32x4 w4 = *(const LAS f32x4*)(gwT + c * 1028 + 256 * j + 4 * lane); a += (v[j].x * w4.x + v[j].y * w4.y) + (v[j].z * w4.z + v[j].w * w4.w); }
                p[c] = a; }
            asm volatile("" ::: "memory");
        }
#pragma unroll
        for (int c = 24; c < 32; ++c) p[c] = 0.f;
        const float val = reduce32(p, lane); const int c = lane >> 1;
        if ((lane & 1) == 0 && c < 24) {
            float o;
            if (c < 8) { o = log_sigmoid(val + A.fox_f_bias[c]); A.KB[(size_t)((m >> 11) * 8 + c) * SEQ + (m & (SEQ - 1))] = o; }
            else if (c < 16) o = val + A.mlstm_i_bias[c - 8];
            else o = log_sigmoid(val + A.mlstm_f_bias[c - 16]);
            A.GATES[(size_t)m * 24 + c] = o;
        }
    }
}

__device__ __forceinline__ void conv_silu32(const bf16* MQK, const float* cw, int cb, long row, int tseq, float (&out)[32]) {
#pragma unroll
    for (int q = 0; q < 4; ++q) {
        float o[8];
#pragma unroll
        for (int i = 0; i < 8; ++i) o[i] = 0.f;
#pragma unroll
        for (int j = 0; j < 4; ++j) {
            v4u w = (v4u){0u, 0u, 0u, 0u};
            if (tseq - 3 + j >= 0) w = *(const GAS v4u*)(MQK + (size_t)(row - 3 + j) * 512 + cb + 8 * q);
            const float* cj = cw + j * 512 + cb + 8 * q;
#pragma unroll
            for (int i = 0; i < 4; ++i) { o[2 * i] += cj[2 * i] * bflo(w[i]); o[2 * i + 1] += cj[2 * i + 1] * bfhi(w[i]); }
        }
#pragma unroll
        for (int i = 0; i < 8; ++i) out[8 * q + i] = o[i] * __builtin_amdgcn_rcpf(1.0f + __expf(-o[i]));
        asm volatile("" ::: "memory"); __builtin_amdgcn_sched_barrier(0);
    }
}
struct MlArgs { const bf16 *MQK, *MV, *MO; const float *GATES, *conv_w, *out_norm_w; float* MST; bf16* MIX; float* KBIAS; float* MPS; };
__device__ __forceinline__ void ml_local_item(const MlArgs& A, int bh, int c, LAS unsigned char* wl, int lane) {
    asm volatile("" : "+v"(lane));
    const int b = bh >> 3, h = bh & 7; const long row = (long)b * SEQ + c * 64 + lane; const int tseq = c * 64 + lane;
    const float fc = A.GATES[(size_t)row * 24 + 16 + h], ic = A.GATES[(size_t)row * 24 + 8 + h];
    const float bcum = wave_scan_sum(fc, lane), blast = readlane_f(bcum, 63);
    const float gg = blast - bcum + ic, a = wave_max(gg), wk = __expf(gg - a);
    float kc[32];
    conv_silu32(A.MQK, A.conv_w, 256 + h * 32, row, tseq, kc);
    LAS float* kw = (LAS float*)wl;
    const float sc = wk * 0.17677669529663687f;
#pragma unroll
    for (int q = 0; q < 8; ++q) *(LAS f32x4*)(kw + lane * 36 + 4 * q) = (f32x4){kc[4 * q] * sc, kc[4 * q + 1] * sc, kc[4 * q + 2] * sc, kc[4 * q + 3] * sc};
    LDS_WAIT(); asm volatile("" ::: "memory");
    float acc[32];
#pragma unroll
    for (int d = 0; d < 32; ++d) acc[d] = 0.f;
    LAS unsigned char* vS = wl + 9216;
    { const GAS v4u* vp = (const GAS v4u*)(A.MV + (size_t)row * 512 + h * 64);
#pragma unroll
      for (int j = 0; j < 8; ++j) { const v4u w = vp[j]; *(LAS unsigned long long*)(vS + lane * 136 + 16 * j) = (unsigned long long)w.x | ((unsigned long long)w.y << 32);
          *(LAS unsigned long long*)(vS + lane * 136 + 16 * j + 8) = (unsigned long long)w.z | ((unsigned long long)w.w << 32); } }
    LDS_WAIT(); asm volatile("" ::: "memory");
#pragma unroll 4
    for (int t = 0; t < 64; ++t) {
        const float vt = bf2f(*(const LAS unsigned short*)(vS + t * 136 + lane * 2));
#pragma unroll
        for (int q = 0; q < 8; ++q) { const f32x4 k4 = *(const LAS f32x4*)(kw + t * 36 + 4 * q); acc[4 * q] += k4.x * vt; acc[4 * q + 1] += k4.y * vt; acc[4 * q + 2] += k4.z * vt; acc[4 * q + 3] += k4.w * vt; }
    }
    float* st = A.MST + (size_t)(bh * 32 + c) * MST_PITCH;
#pragma unroll
    for (int d = 0; d < 32; ++d) st[d * 64 + lane] = acc[d];
    if (lane < 32) { float n = 0.f; for (int t = 0; t < 64; ++t) n += kw[t * 36 + lane]; st[2048 + lane] = n; }
    if (lane == 0) { st[2048 + 32] = a; st[2048 + 33] = blast; }
    LDS_WAIT(); asm volatile("" ::: "memory");
}
__device__ __forceinline__ void fox_cumsum_item(const MlArgs& A, int bh, int lane) {
    float* o = A.KBIAS + (size_t)bh * SEQ + lane * 32;
    float v[32]; float s = 0.f;
#pragma unroll
    for (int q = 0; q < 8; ++q) { const f32x4 x = *(const f32x4*)(o + 4 * q); v[4 * q] = x.x; v[4 * q + 1] = x.y; v[4 * q + 2] = x.z; v[4 * q + 3] = x.w; }
#pragma unroll
    for (int i = 0; i < 32; ++i) { s += v[i]; v[i] = s; }
    const float excl = wave_scan_sum(s, lane) - s;
#pragma unroll
    for (int q = 0; q < 8; ++q) *(f32x4*)(o + 4 * q) = (f32x4){-(excl + v[4 * q]) * LOG2E, -(excl + v[4 * q + 1]) * LOG2E, -(excl + v[4 * q + 2]) * LOG2E, -(excl + v[4 * q + 3]) * LOG2E};
}
__device__ __forceinline__ void ml_scan_item(const MlArgs& A, int bh, int slice, int lane) {
    const float* stb = A.MST + (size_t)(bh * 32) * MST_PITCH; float* psb = A.MPS + (size_t)(bh * 32) * MST_PITCH;
    float aB = 0.f, aA = 0.f;
    if (lane < 32) { aB = stb[(size_t)lane * MST_PITCH + 2048 + 33]; aA = stb[(size_t)lane * MST_PITCH + 2048 + 32]; }
    float dec = 0.f, wk = 0.f, mst = 0.f, m = 0.f;
#pragma unroll 1
    for (int c = 0; c < 32; ++c) {
        const float Bc = readlane_f(aB, c), ac = readlane_f(aA, c), mn = fmaxf(Bc + m, ac);
        if (lane == c) { dec = __expf(Bc + m - mn); wk = __expf(ac - mn); mst = m; }
        m = mn;
    }
    const int el = slice < 32 ? slice * 64 + lane : 2048 + (lane & 31);
    float ld[32];
#pragma unroll
    for (int c = 0; c < 32; ++c) ld[c] = stb[(size_t)c * MST_PITCH + el];
    float x = 0.f;
#pragma unroll
    for (int c = 0; c < 32; ++c) {
        float o = x; if (slice == 32 && lane == 32) o = readlane_f(mst, c);
        if (slice < 32 || lane <= 32) psb[(size_t)c * MST_PITCH + (slice < 32 ? el : 2048 + lane)] = o;
        x = readlane_f(dec, c) * x + readlane_f(wk, c) * ld[c];
    }
}
constexpr int ML_WL = 17536;
__device__ __forceinline__ void ml_output_item(const MlArgs& A, int bh, int c, LAS unsigned char* wl, int lane) {
    asm volatile("" : "+v"(lane));
    const int b = bh >> 3, h = bh & 7; const long row0 = (long)b * SEQ + c * 64, row = row0 + lane; const int tseq = c * 64 + lane;
    LAS unsigned char* kL = wl; LAS unsigned char* vL = wl + 4096; LAS unsigned char* cL = wl + 9216; LAS unsigned char* hL = wl + 13312;
    LAS float* nsL = (LAS float*)(wl + 17408);
    const float fc = A.GATES[(size_t)row * 24 + 16 + h], ic = A.GATES[(size_t)row * 24 + 8 + h];
    const float bcum = wave_scan_sum(fc, lane);
    const float beta = ic - bcum, pmax = wave_scan_max(beta, lane);
    const float* ps = A.MPS + (size_t)(bh * 32 + c) * MST_PITCH;
    const float mprev = ps[2048 + 32];
    const float inter = bcum + mprev, m_t = fmaxf(inter, bcum + pmax), w_inter = __expf(inter - m_t), alpha = bcum - m_t;
    {
        float Cs[32];
#pragma unroll
        for (int d = 0; d < 32; ++d) Cs[d] = ps[d * 64 + lane];
        const float ns = ps[2048 + (lane & 31)];
#pragma unroll
        for (int d = 0; d < 32; ++d) *(LAS unsigned short*)(cL + d * 128 + lane * 2) = (unsigned short)f2bf(Cs[d]);
        if (lane < 32) nsL[lane] = ns;
    }
    __builtin_amdgcn_sched_barrier(0);
    float q[32];
    { float kc[32]; conv_silu32(A.MQK, A.conv_w, 256 + h * 32, row, tseq, kc);
#pragma unroll
      for (int j = 0; j < 4; ++j) { v4u o;
#pragma unroll
          for (int i = 0; i < 4; ++i) o[i] = pk2(kc[8 * j + 2 * i] * 0.17677669529663687f, kc[8 * j + 2 * i + 1] * 0.17677669529663687f);
          *(LAS v4u*)(kL + lane * 64 + 16 * j) = o; } }
    __builtin_amdgcn_sched_barrier(0);
    conv_silu32(A.MQK, A.conv_w, h * 32, row, tseq, q);
    LDS_WAIT(); asm volatile("" ::: "memory"); __builtin_amdgcn_sched_barrier(0);
    float den = 0.f, dinv = 0.f, ss = 0.f;
    {
        float qn = 0.f;
#pragma unroll
        for (int j = 0; j < 8; ++j) { const f32x4 n4 = *(const LAS f32x4*)(nsL + 4 * j); qn += (q[4 * j] * n4.x + q[4 * j + 1] * n4.y) + (q[4 * j + 2] * n4.z + q[4 * j + 3] * n4.w); }
        den = w_inter * qn;
    }
    float acc[32];
#pragma unroll 1
    for (int eh = 0; eh < 2; ++eh) {
        float wint = w_inter; asm volatile("" : "+v"(wint));
        { const GAS v4u* vp = (const GAS v4u*)(A.MV + (size_t)row * 512 + h * 64 + 32 * eh);
#pragma unroll
          for (int j = 0; j < 4; ++j) *(LAS v4u*)(vL + lane * 80 + 16 * j) = vp[j]; }
#pragma unroll
        for (int e = 0; e < 32; ++e) acc[e] = 0.f;
#pragma unroll
        for (int d = 0; d < 32; ++d) { float qd = q[d] * wint; asm volatile("" : "+v"(qd));
#pragma unroll
            for (int j = 0; j < 4; ++j) { const v4u cv = *(const LAS v4u*)(cL + d * 128 + 64 * eh + 16 * j);
#pragma unroll
                for (int i = 0; i < 4; ++i) { fmac_s(acc[8 * j + 2 * i], qd, bflo(cv[i])); fmac_s(acc[8 * j + 2 * i + 1], qd, bfhi(cv[i])); } }
            if ((d & 1) == 1) { asm volatile("" ::: "memory"); __builtin_amdgcn_sched_barrier(0); } }
        LDS_WAIT(); asm volatile("" ::: "memory");
#pragma unroll 1
        for (int s = 0; s < 64; ++s) {
            float qk = 0.f;
#pragma unroll
            for (int j = 0; j < 4; ++j) { const v4u kv = *(const LAS v4u*)(kL + s * 64 + 16 * j);
#pragma unroll
                for (int i = 0; i < 4; ++i) { fmac_s(qk, q[8 * j + 2 * i], bflo(kv[i])); fmac_s(qk, q[8 * j + 2 * i + 1], bfhi(kv[i])); } }
            const float bs = readlane_f(beta, s);
            const float S = (s <= lane) ? qk * __expf(alpha + bs) : 0.f;
            if (eh == 0) den += S;
#pragma unroll
            for (int j = 0; j < 4; ++j) { const v4u vv = *(const LAS v4u*)(vL + s * 80 + 16 * j);
#pragma unroll
                for (int i = 0; i < 4; ++i) { fmac_s(acc[8 * j + 2 * i], S, bflo(vv[i])); fmac_s(acc[8 * j + 2 * i + 1], S, bfhi(vv[i])); } }
        }
        if (eh == 0) dinv = 1.0f / fmaxf(fabsf(den), __expf(-m_t));
#pragma unroll
        for (int e = 0; e < 32; ++e) { acc[e] *= dinv; ss += acc[e] * acc[e]; }
        if (eh == 0) {
#pragma unroll
            for (int j = 0; j < 4; ++j) { v4u o;
#pragma unroll
                for (int i = 0; i < 4; ++i) o[i] = pk2(acc[8 * j + 2 * i], acc[8 * j + 2 * i + 1]);
                *(LAS v4u*)(hL + lane * 64 + 16 * j) = o; }
        }
        LDS_WAIT(); asm volatile("" ::: "memory"); __builtin_amdgcn_sched_barrier(0);
    }
    const float rstd = 1.0f / sqrtf(ss * (1.0f / 64.0f) + NORM_EPS);
    const GAS v4u* mop = (const GAS v4u*)(A.MO + (size_t)row * 512 + h * 64);
    GAS v4u* op = (GAS v4u*)(A.MIX + (size_t)row * DMODEL + 512 + h * 64);
    const float* wn = A.out_norm_w + h * 64;
#pragma unroll
    for (int j = 0; j < 8; ++j) { const v4u mo = mop[j]; v4u o; v4u h0 = (v4u){0u, 0u, 0u, 0u};
        if (j < 4) h0 = *(const LAS v4u*)(hL + lane * 64 + 16 * j);
#pragma unroll
        for (int i = 0; i < 4; ++i) { const float g0 = __builtin_amdgcn_rcpf(1.0f + __expf(-bflo(mo[i]))), g1 = __builtin_amdgcn_rcpf(1.0f + __expf(-bfhi(mo[i])));
            const float a0 = j < 4 ? bflo(h0[i]) : acc[8 * (j & 3) + 2 * i], a1 = j < 4 ? bfhi(h0[i]) : acc[8 * (j & 3) + 2 * i + 1];
            o[i] = pk2(a0 * rstd * wn[8 * j + 2 * i] * g0, a1 * rstd * wn[8 * j + 2 * i + 1] * g1); }
        op[j] = o; asm volatile("" ::: "memory"); __builtin_amdgcn_sched_barrier(0); }
    LDS_WAIT(); asm volatile("" ::: "memory");
}

constexpr int ML_WL2 = 17024;
__device__ __forceinline__ attn_body::bf16x8 ml_pack8(const attn_body::f32x16& P, int b) {
    attn_body::u32x4 w; w[0] = attn_body::cvtpk_s(P[b], P[b + 1]); w[1] = attn_body::cvtpk_s(P[b + 2], P[b + 3]); w[2] = attn_body::cvtpk_s(P[b + 4], P[b + 5]); w[3] = attn_body::cvtpk_s(P[b + 6], P[b + 7]);
    return __builtin_bit_cast(attn_body::bf16x8, w);
}
__device__ __forceinline__ float ml_weight_tile(attn_body::f32x16& P, const LAS float* betaL, int kvb, int hi, int tq, float a_q) {
    float sum = 0.f;
#pragma unroll
    for (int g = 0; g < 4; ++g) { const f32x4 bt = *(const LAS f32x4*)(betaL + 32 * kvb + 8 * g + 4 * hi);
#pragma unroll
        for (int i = 0; i < 4; ++i) { const int kv = 32 * kvb + 8 * g + 4 * hi + i; const float e = (kv <= tq) ? __expf(a_q + bt[i]) : 0.f; P[4 * g + i] *= e; sum += P[4 * g + i]; } }
    return sum;
}
__device__ __forceinline__ void ml_output_item_mfma(const MlArgs& A, int bh, int c, LAS unsigned char* wl, int lane, unsigned long long* tp = nullptr) {
    unsigned long long t0_ = tp ? __builtin_amdgcn_s_memrealtime() : 0ull;
#define MLT(i_) do { if (tp) { const unsigned long long t_ = __builtin_amdgcn_s_memrealtime(); if (threadIdx.x == 0) tp[i_] = t_ - t0_; t0_ = t_; } } while (0)
    using attn_body::f32x16; using attn_body::bf16x8; using attn_body::s16x4; using attn_body::lds_cptr; using attn_body::u32x4;
    asm volatile("" : "+v"(lane));
    const int b = bh >> 3, h = bh & 7; const long row0 = (long)b * SEQ + c * 64, row = row0 + lane; const int tseq = c * 64 + lane;
    const int r32 = lane & 31, hi = lane >> 5;
    LAS unsigned char* kI = wl; LAS unsigned char* qI = wl + 4096; LAS unsigned char* vI = wl + 8192;
    LAS float* betaL = (LAS float*)(wl + 16384); LAS float* dinvL = betaL + 64; LAS float* nsL = dinvL + 64;
    const float fc = A.GATES[(size_t)row * 24 + 16 + h], ic = A.GATES[(size_t)row * 24 + 8 + h];
    const float bcum = wave_scan_sum(fc, lane);
    const float beta = ic - bcum, pmax = wave_scan_max(beta, lane);
    const float* ps = A.MPS + (size_t)(bh * 32 + c) * MST_PITCH;
    const float mprev = ps[2048 + 32];
    const float inter = bcum + mprev, m_t = fmaxf(inter, bcum + pmax), w_inter = __expf(inter - m_t), alpha = bcum - m_t, em = __expf(-m_t);
    betaL[lane] = beta;
    if (lane < 32) nsL[lane] = ps[2048 + lane];
    { float kc[32]; conv_silu32(A.MQK, A.conv_w, 256 + h * 32, row, tseq, kc);
#pragma unroll
      for (int j = 0; j < 4; ++j) { v4u o;
#pragma unroll
          for (int i = 0; i < 4; ++i) o[i] = pk2(kc[8 * j + 2 * i] * 0.17677669529663687f, kc[8 * j + 2 * i + 1] * 0.17677669529663687f);
          *(LAS v4u*)(kI + j * 1024 + lane * 16) = o; } }
    __builtin_amdgcn_sched_barrier(0);
    float den_inter;
    { float q[32]; conv_silu32(A.MQK, A.conv_w, h * 32, row, tseq, q);
#pragma unroll
      for (int j = 0; j < 4; ++j) { v4u o;
#pragma unroll
          for (int i = 0; i < 4; ++i) o[i] = pk2(q[8 * j + 2 * i], q[8 * j + 2 * i + 1]);
          *(LAS v4u*)(qI + j * 1024 + lane * 16) = o; }
      LDS_WAIT(); asm volatile("" ::: "memory");
      float qn = 0.f;
#pragma unroll
      for (int j = 0; j < 8; ++j) { const f32x4 n4 = *(const LAS f32x4*)(nsL + 4 * j); qn += (q[4 * j] * n4.x + q[4 * j + 1] * n4.y) + (q[4 * j + 2] * n4.z + q[4 * j + 3] * n4.w); }
      den_inter = w_inter * qn; }
    { const GAS v4u* vp = (const GAS v4u*)(A.MV + (size_t)row * 512 + h * 64);
#pragma unroll
      for (int j = 0; j < 8; ++j) *(LAS v4u*)(vI + (j >> 2) * 4096 + lane * 64 + (j & 3) * 16) = vp[j]; }
    float Cs[32];
#pragma unroll
    for (int d = 0; d < 32; ++d) Cs[d] = ps[d * 64 + lane];
    LDS_WAIT(); asm volatile("" ::: "memory"); __builtin_amdgcn_sched_barrier(0);
    MLT(0);
    bf16x8 qr[2][2];
#pragma unroll
    for (int tb = 0; tb < 2; ++tb)
#pragma unroll
        for (int d0 = 0; d0 < 2; ++d0) qr[tb][d0] = *(const LAS bf16x8*)(qI + (2 * d0 + hi) * 1024 + (32 * tb + r32) * 16);
    f32x16 p00 = f32x16{}, p10 = f32x16{}, p11 = f32x16{};
#pragma unroll
    for (int d0 = 0; d0 < 2; ++d0) {
        const bf16x8 kf0 = *(const LAS bf16x8*)(kI + (2 * d0 + hi) * 1024 + r32 * 16), kf1 = *(const LAS bf16x8*)(kI + (2 * d0 + hi) * 1024 + (32 + r32) * 16);
        p00 = __builtin_amdgcn_mfma_f32_32x32x16_bf16(kf0, qr[0][d0], p00, 0, 0, 0);
        p10 = __builtin_amdgcn_mfma_f32_32x32x16_bf16(kf0, qr[1][d0], p10, 0, 0, 0);
        p11 = __builtin_amdgcn_mfma_f32_32x32x16_bf16(kf1, qr[1][d0], p11, 0, 0, 0);
    }
    float wq[2];
    bf16x8 pa0[2], pa1[4];
    {
        const int tq = r32; const float a_q = __shfl(alpha, tq);
        float ds = ml_weight_tile(p00, betaL, 0, hi, tq, a_q);
        { auto rr = __builtin_amdgcn_permlane32_swap(__float_as_uint(ds), __float_as_uint(ds), false, false); ds = __uint_as_float(rr[0]) + __uint_as_float(rr[1]); }
        const float den = __shfl(den_inter, tq) + ds, dinv = __builtin_amdgcn_rcpf(fmaxf(fabsf(den), __shfl(em, tq)));
        if (hi == 0) dinvL[tq] = dinv;
        wq[0] = __shfl(w_inter, tq);
        pa0[0] = ml_pack8(p00, 0); pa0[1] = ml_pack8(p00, 8);
    }
    {
        const int tq = 32 + r32; const float a_q = __shfl(alpha, tq);
        float ds = ml_weight_tile(p10, betaL, 0, hi, tq, a_q) + ml_weight_tile(p11, betaL, 1, hi, tq, a_q);
        { auto rr = __builtin_amdgcn_permlane32_swap(__float_as_uint(ds), __float_as_uint(ds), false, false); ds = __uint_as_float(rr[0]) + __uint_as_float(rr[1]); }
        const float den = __shfl(den_inter, tq) + ds, dinv = __builtin_amdgcn_rcpf(fmaxf(fabsf(den), __shfl(em, tq)));
        if (hi == 0) dinvL[tq] = dinv;
        wq[1] = __shfl(w_inter, tq);
        pa1[0] = ml_pack8(p10, 0); pa1[1] = ml_pack8(p10, 8); pa1[2] = ml_pack8(p11, 0); pa1[3] = ml_pack8(p11, 8);
    }
    LDS_WAIT(); asm volatile("" ::: "memory");
#pragma unroll
    for (int j = 0; j < 4; ++j) { v4u o;
#pragma unroll
        for (int i = 0; i < 4; ++i) o[i] = pk2(Cs[8 * j + 2 * i], Cs[8 * j + 2 * i + 1]);
        *(LAS v4u*)(kI + lane * 64 + 16 * j) = o; }
    LDS_WAIT(); asm volatile("" ::: "memory"); __builtin_amdgcn_sched_barrier(0);
    MLT(1);
    f32x16 o[2][2];
    const lds_cptr vb = (lds_cptr)vI + ((lane >> 4) & 1) * 32 + (lane & 3) * 8 + (4 * hi + ((lane & 15) >> 2)) * 64;
#pragma unroll
    for (int tb = 0; tb < 2; ++tb) {
        bf16x8 qw[2];
#pragma unroll
        for (int ks = 0; ks < 2; ++ks) { const u32x4 w = __builtin_bit_cast(u32x4, qr[tb][ks]); u32x4 r;
#pragma unroll
            for (int i = 0; i < 4; ++i) r[i] = attn_body::cvtpk_s(bflo(w[i]) * wq[tb], bfhi(w[i]) * wq[tb]);
            qw[ks] = __builtin_bit_cast(bf16x8, r); }
#pragma unroll
        for (int e0 = 0; e0 < 2; ++e0) {
            f32x16 acc = f32x16{};
#pragma unroll
            for (int ks = 0; ks < 4; ++ks) { if (tb == 0 && ks >= 2) continue;
                const s16x4 lo = attn_body::vtr(vb + e0 * 4096 + ks * 1024), hv = attn_body::vtr(vb + e0 * 4096 + ks * 1024 + 512);
                const bf16x8 vf = (bf16x8){lo[0], lo[1], lo[2], lo[3], hv[0], hv[1], hv[2], hv[3]};
                acc = __builtin_amdgcn_mfma_f32_32x32x16_bf16(tb == 0 ? pa0[ks & 1] : pa1[ks], vf, acc, 0, 0, 0); }
#pragma unroll
            for (int ks = 0; ks < 2; ++ks) { const bf16x8 cf = *(const LAS bf16x8*)(kI + (32 * e0 + r32) * 64 + (16 * ks + 8 * hi) * 2);
                acc = __builtin_amdgcn_mfma_f32_32x32x16_bf16(qw[ks], cf, acc, 0, 0, 0); }
            o[tb][e0] = acc;
        }
    }
    MLT(2);
    const float* wn = A.out_norm_w + h * 64;
#pragma unroll
    for (int tb = 0; tb < 2; ++tb) {
        LDS_WAIT(); asm volatile("" ::: "memory");
        LAS unsigned short* stg = (LAS unsigned short*)kI;
#pragma unroll
        for (int g = 0; g < 4; ++g) { const f32x4 dv = *(const LAS f32x4*)(dinvL + 32 * tb + 8 * g + 4 * hi);
#pragma unroll
            for (int i = 0; i < 4; ++i) { const int orow = 8 * g + 4 * hi + i;
                stg[orow * 64 + r32] = (unsigned short)f2bf(o[tb][0][4 * g + i] * dv[i]); stg[orow * 64 + 32 + r32] = (unsigned short)f2bf(o[tb][1][4 * g + i] * dv[i]); } }
        LDS_WAIT(); asm volatile("" ::: "memory");
#pragma unroll
        for (int i = 0; i < 4; ++i) { const int rl = i * 8 + (lane >> 3), ch = lane & 7; const v4u v = *(const LAS v4u*)(kI + rl * 128 + ch * 16);
            float x[8];
#pragma unroll
            for (int j = 0; j < 4; ++j) { x[2 * j] = bflo(v[j]); x[2 * j + 1] = bfhi(v[j]); }
            float ss = 0.f;
#pragma unroll
            for (int j = 0; j < 8; ++j) ss += x[j] * x[j];
            ss += __shfl_xor(ss, 1); ss += __shfl_xor(ss, 2); ss += __shfl_xor(ss, 4);
            const float rs = __builtin_amdgcn_rsqf(ss * (1.0f / 64.0f) + NORM_EPS);
            const long orow = row0 + 32 * tb + rl;
            const v4u mo = *(const GAS v4u*)(A.MO + (size_t)orow * 512 + h * 64 + ch * 8); v4u ov;
#pragma unroll
            for (int j = 0; j < 4; ++j) { const float g0 = __builtin_amdgcn_rcpf(1.0f + __expf(-bflo(mo[j]))), g1 = __builtin_amdgcn_rcpf(1.0f + __expf(-bfhi(mo[j])));
                ov[j] = pk2(x[2 * j] * rs * wn[ch * 8 + 2 * j] * g0, x[2 * j + 1] * rs * wn[ch * 8 + 2 * j + 1] * g1); }
            *(GAS v4u*)(A.MIX + (size_t)orow * DMODEL + 512 + h * 64 + ch * 8) = ov; }
    }
    LDS_WAIT(); asm volatile("" ::: "memory");
    MLT(3);
#undef MLT
}

struct RtArgs { bf16* x1; const float* x; const float *moe_norm_w, *router_w, *router_b;
                 unsigned char* H2; int* TOPI; float* TOPW; int* HIST; };
__device__ __forceinline__ void p5_router(const RtArgs& A, LAS unsigned char* lds, int vcu, int G, int tid, int lane, int wave, unsigned long long* tp = nullptr) {
    unsigned long long t0_ = tp ? __builtin_amdgcn_s_memrealtime() : 0ull, tA = 0, tB = 0, tC = 0, tD = 0;
#define P5T(acc) do { if (tp) { const unsigned long long t_ = __builtin_amdgcn_s_memrealtime(); acc += t_ - t0_; t0_ = t_; } } while (0)
    LAS float* rwT = (LAS float*)lds;
    LAS int* hist = (LAS int*)(lds + 32 * 1028 * 4);
#pragma unroll 4
    for (int j = 0; j < 16; ++j) { const int idx = tid + 512 * j, k = idx >> 3, e4 = (idx & 7) * 4; const f32x4 w4 = *(const GAS f32x4*)(A.router_w + (size_t)idx * 4);
        rwT[(e4 + 0) * 1028 + k] = w4.x; rwT[(e4 + 1) * 1028 + k] = w4.y; rwT[(e4 + 2) * 1028 + k] = w4.z; rwT[(e4 + 3) * 1028 + k] = w4.w; }
    f32x4 wn[4];
#pragma unroll
    for (int j = 0; j < 4; ++j) wn[j] = *(const f32x4*)(A.moe_norm_w + 4 * lane + 256 * j);
    const float rb = A.router_b[lane >> 1];
    for (int seg = vcu; seg < NSEG; seg += G) {
        if (tid < 32) hist[tid] = 0;
        __syncthreads();
        P5T(tA);
        f32x4 vn[2][4];
#pragma unroll
        for (int u = 0; u < 2; ++u)
#pragma unroll
            for (int j = 0; j < 4; ++j) { const unsigned long long w = ((const GAS unsigned long long*)(A.x1 + (size_t)(seg * 64 + wave * 8 + u) * DMODEL) + lane)[64 * j]; vn[u][j] = ((const GAS f32x4*)(A.x + (size_t)(seg * 64 + wave * 8 + u) * DMODEL) + lane)[64 * j] + (f32x4){bflo((unsigned)w), bfhi((unsigned)w), bflo((unsigned)(w >> 32)), bfhi((unsigned)(w >> 32))}; }
#pragma unroll 1
        for (int i = 0; i < 4; ++i) {
            const int m0 = seg * 64 + wave * 8 + 2 * i;
            f32x4 v[2][4];
#pragma unroll
            for (int u = 0; u < 2; ++u)
#pragma unroll
                for (int j = 0; j < 4; ++j) v[u][j] = vn[u][j];
            if (i < 3) {
#pragma unroll
                for (int u = 0; u < 2; ++u)
#pragma unroll
                    for (int j = 0; j < 4; ++j) { const unsigned long long w = ((const GAS unsigned long long*)(A.x1 + (size_t)(m0 + 2 + u) * DMODEL) + lane)[64 * j]; vn[u][j] = ((const GAS f32x4*)(A.x + (size_t)(m0 + 2 + u) * DMODEL) + lane)[64 * j] + (f32x4){bflo((unsigned)w), bfhi((unsigned)w), bflo((unsigned)(w >> 32)), bfhi((unsigned)(w >> 32))}; }
            }
#pragma unroll
            for (int u = 0; u < 2; ++u) {
                float s = 0.f;
#pragma unroll
                for (int j = 0; j < 4; ++j) { s += (v[u][j].x * v[u][j].x + v[u][j].y * v[u][j].y) + (v[u][j].z * v[u][j].z + v[u][j].w * v[u][j].w); }
                const float rstd = 1.f / sqrtf(wave_sum(s) * (1.f / DMODEL) + NORM_EPS);
                { GAS unsigned long long* x8 = (GAS unsigned long long*)(A.x1 + (size_t)(m0 + u) * DMODEL) + lane;
#pragma unroll
                  for (int j = 0; j < 4; ++j) x8[64 * j] = (unsigned long long)pk2(v[u][j].x, v[u][j].y) | ((unsigned long long)pk2(v[u][j].z, v[u][j].w) << 32); }
                GAS unsigned* o4 = (GAS unsigned*)(A.H2 + (size_t)(m0 + u) * DMODEL) + lane;
#pragma unroll
                for (int j = 0; j < 4; ++j) { v[u][j] = v[u][j] * rstd * wn[j]; int pk = __builtin_amdgcn_cvt_pk_fp8_f32(v[u][j].x, v[u][j].y, 0, false); pk = __builtin_amdgcn_cvt_pk_fp8_f32(v[u][j].z, v[u][j].w, pk, true); o4[64 * j] = (unsigned)pk; }
            }
            P5T(tB);
            typedef float f32x2r __attribute__((ext_vector_type(2)));
            f32x2r pp[32];
#pragma unroll
            for (int e = 0; e < 32; ++e) pp[e] = (f32x2r){0.f, 0.f};
#pragma unroll 1
            for (int j = 0; j < 4; ++j) {
                const f32x4 a = j == 0 ? v[0][0] : (j == 1 ? v[0][1] : (j == 2 ? v[0][2] : v[0][3])), b = j == 0 ? v[1][0] : (j == 1 ? v[1][1] : (j == 2 ? v[1][2] : v[1][3]));
                const f32x2r ab0 = {a.x, b.x}, ab1 = {a.y, b.y}, ab2 = {a.z, b.z}, ab3 = {a.w, b.w};
                const LAS float* wp = rwT + 256 * j + 4 * lane;
#pragma unroll
                for (int e = 0; e < 32; ++e) { const f32x4 w4 = *(const LAS f32x4*)(wp + e * 1028);
                    pp[e] = __builtin_elementwise_fma(ab0, (f32x2r){w4.x, w4.x}, pp[e]); pp[e] = __builtin_elementwise_fma(ab1, (f32x2r){w4.y, w4.y}, pp[e]);
                    pp[e] = __builtin_elementwise_fma(ab2, (f32x2r){w4.z, w4.z}, pp[e]); pp[e] = __builtin_elementwise_fma(ab3, (f32x2r){w4.w, w4.w}, pp[e]);
                    if ((e & 7) == 7) asm volatile("" ::: "memory"); }
            }
            float p0[32], p1[32];
#pragma unroll
            for (int e = 0; e < 32; ++e) { p0[e] = pp[e].x; p1[e] = pp[e].y; }
            P5T(tC);
            {
                const float lg0 = reduce32(p0, lane) + rb, lg1 = reduce32(p1, lane) + rb;
                const int e = lane >> 1; int rk0 = 0, rk1 = 0;
#pragma unroll 4
                for (int o = 0; o < 32; ++o) { const float a0 = readlane_f(lg0, 2 * o), a1 = readlane_f(lg1, 2 * o);
                    rk0 += (a0 > lg0 || (a0 == lg0 && o < e)) ? 1 : 0; rk1 += (a1 > lg1 || (a1 == lg1 && o < e)) ? 1 : 0; }
#pragma unroll
                for (int u = 0; u < 2; ++u) {
                    const float logit = u == 0 ? lg0 : lg1; const int rank = u == 0 ? rk0 : rk1;
                    int te[4]; float tv[4];
#pragma unroll
                    for (int k = 0; k < 4; ++k) { const unsigned long long mk = __ballot(rank == k && (lane & 1) == 0); const int src = __builtin_ctzll(mk); te[k] = src >> 1; tv[k] = readlane_f(logit, src); }
                    const float e1 = __expf(tv[1] - tv[0]), e2 = __expf(tv[2] - tv[0]), e3 = __expf(tv[3] - tv[0]), inv = __builtin_amdgcn_rcpf(1.0f + e1 + e2 + e3);
                    if (lane == 0) {
                        *(int4*)(A.TOPI + (size_t)(m0 + u) * 4) = make_int4(te[0], te[1], te[2], te[3]);
                        *(float4*)(A.TOPW + (size_t)(m0 + u) * 4) = make_float4(inv, e1 * inv, e2 * inv, e3 * inv);
                        for (int k = 0; k < 4; ++k) __hip_atomic_fetch_add(hist + te[k], 1, __ATOMIC_RELAXED, __HIP_MEMORY_SCOPE_WORKGROUP);
                    }
                }
            }
            P5T(tD);
        }
        P5T(tD);
        __syncthreads();
        if (tid < 32) A.HIST[seg * 32 + tid] = hist[tid];
        __syncthreads();
    }
    if (tp && tid == 0) { tp[0] = tA; tp[1] = tB; tp[2] = tC; tp[3] = tD; }
#undef P5T
}

struct DsArgs { const int* TOPI; const float* TOPW; const int* HIST; int* POSSLOT; int* TOKPOS; float* GATEPOS; int* TILEPREF; };
__device__ __forceinline__ void p6_dispatch(const DsArgs& A, LAS unsigned char* lds, int vcu, int G, int tid) {
    LAS int* pb = (LAS int*)lds;
    LAS int* pt = pb + 512;
    LAS int* nE = pt + 512;
    LAS int* base = nE + 32;
    LAS int* pst = base + 32;
    LAS int* es = pst + 64;
    for (int seg = vcu; seg < NSEG; seg += G) {
        { const int e = tid & 31, j = tid >> 5; int below = 0, tot = 0;
          for (int s = 16 * j; s < 16 * j + 16; ++s) { const int hv = A.HIST[s * 32 + e]; tot += hv; if (s < seg) below += hv; }
          pb[j * 32 + e] = below; pt[j * 32 + e] = tot; }
        if (tid < 256) es[tid] = A.TOPI[(size_t)seg * 256 + tid];
        __syncthreads();
        if (tid < 32) { int n = 0, o = 0; for (int j = 0; j < 16; ++j) { n += pt[j * 32 + tid]; o += pb[j * 32 + tid]; } nE[tid] = n; base[tid] = o; }
        __syncthreads();
        if (tid < 32) { int ps = 0; for (int e = 0; e < tid; ++e) ps += (nE[e] + 255) >> 8; pst[tid] = ps * 256; base[tid] += ps * 256;
                        if (tid == 31) pst[32] = (ps + ((nE[31] + 255) >> 8)) * 256; }
        __syncthreads();
        if (tid < 256) {
            const int e = es[tid]; int rank = 0;
            for (int i = 0; i < tid; ++i) rank += (es[i] == e) ? 1 : 0;
            const int pos = base[e] + rank, slot = seg * 256 + tid;
            A.POSSLOT[slot] = pos; A.TOKPOS[pos] = slot >> 2; A.GATEPOS[pos] = A.TOPW[slot];
        }
        if (seg == 0 && tid <= 32) A.TILEPREF[tid] = pst[tid] >> 8;
        if (seg == 0 && tid == 0) {
            unsigned used = 0u;
            for (int k = 0; k < NE; ++k) { int best = -1, bm = -1; for (int e = 0; e < NE; ++e) { const int m = (nE[e] + 255) >> 8; if (!((used >> e) & 1u) && m > bm) { bm = m; best = e; } }
                used |= 1u << best; const int j = k >> 3, g = (j & 1) ? 7 - (k & 7) : (k & 7); A.TILEPREF[33 + g + 8 * j] = best; }
        }
        if (seg < NE) { const int e = seg, p0 = pst[e] + nE[e], p1 = pst[e + 1];
            for (int p = p0 + tid; p < p1; p += NWAVES * 64) { A.TOKPOS[p] = 0; A.GATEPOS[p] = 0.f; } }
        __syncthreads();
    }
}

template <int K> __device__ __forceinline__ float f8b(unsigned w) { return __builtin_amdgcn_cvt_f32_fp8((int)w, K); }
__device__ __forceinline__ void p9_combine(float* out, const bf16* X1, const unsigned char* Y, const int* POSSLOT, int vcu, int G, int lane, int wave) {
    const int gw = vcu * NWAVES + wave, NGW = G * NWAVES;
    for (int m0 = gw; m0 < MTOK; m0 += 4 * NGW) {
        int4 ps[4];
#pragma unroll
        for (int i = 0; i < 4; ++i) { const int m = m0 + i * NGW; ps[i] = (m < MTOK) ? *(const int4*)(POSSLOT + (size_t)m * 4) : make_int4(0, 0, 0, 0); }
#pragma unroll
        for (int i = 0; i < 4; ++i) {
            const int m = m0 + i * NGW; if (m >= MTOK) break;
            GAS f32x4* xr = (GAS f32x4*)(out + (size_t)m * DMODEL) + lane;
            const GAS unsigned long long* x1r = (const GAS unsigned long long*)(X1 + (size_t)m * DMODEL) + lane;
            const GAS unsigned* y0 = (const GAS unsigned*)(Y + (size_t)ps[i].x * DMODEL) + lane;
            const GAS unsigned* y1 = (const GAS unsigned*)(Y + (size_t)ps[i].y * DMODEL) + lane;
            const GAS unsigned* y2 = (const GAS unsigned*)(Y + (size_t)ps[i].z * DMODEL) + lane;
            const GAS unsigned* y3 = (const GAS unsigned*)(Y + (size_t)ps[i].w * DMODEL) + lane;
            unsigned long long xw[4]; unsigned a[4], b[4], c[4], d[4];
#pragma unroll
            for (int j = 0; j < 4; ++j) { xw[j] = x1r[64 * j]; a[j] = y0[64 * j]; b[j] = y1[64 * j]; c[j] = y2[64 * j]; d[j] = y3[64 * j]; }
#pragma unroll
            for (int j = 0; j < 4; ++j) {
                f32x4 v = (f32x4){bflo((unsigned)xw[j]), bfhi((unsigned)xw[j]), bflo((unsigned)(xw[j] >> 32)), bfhi((unsigned)(xw[j] >> 32))};
                v.x += (f8b<0>(a[j]) + f8b<0>(b[j])) + (f8b<0>(c[j]) + f8b<0>(d[j]));
                v.y += (f8b<1>(a[j]) + f8b<1>(b[j])) + (f8b<1>(c[j]) + f8b<1>(d[j]));
                v.z += (f8b<2>(a[j]) + f8b<2>(b[j])) + (f8b<2>(c[j]) + f8b<2>(d[j]));
                v.w += (f8b<3>(a[j]) + f8b<3>(b[j])) + (f8b<3>(c[j]) + f8b<3>(d[j]));
                xr[64 * j] = v;
            }
        }
    }
}

struct Args { const float* in[19]; float* out; unsigned char* ws; int ph_lo, ph_hi, li, pad; };
__global__ void __launch_bounds__(NWAVES * 64, 2) hymba_fwd(Args args) {
    extern __shared__ __attribute__((aligned(16))) unsigned char lds_raw[];
    LAS unsigned char* lds = (LAS unsigned char*)lds_raw;
    volatile LAS unsigned* MISC = (volatile LAS unsigned*)(lds + MISC_OFF);
    const int tid0 = threadIdx.x, wave = __builtin_amdgcn_readfirstlane(tid0 >> 6);
#define PHASE_TID() int tid = tid0; asm volatile("" : "+v"(tid)); const int lane = tid & 63; (void)lane
    const int G = gridDim.x; int vcu = (G % 8 == 0) ? ((int)blockIdx.x % 8) * (G / 8) + (int)blockIdx.x / 8 : (int)blockIdx.x;
    int cvirt = (int)blockIdx.x;
    unsigned char* ws = args.ws;
    gu32* ctl = (gu32*)(ws + WS_CTL);
    for (int u = tid0; u < (LDS_BYTES - LDSCTL_OFF) / 4; u += NWAVES * 64) ((LAS unsigned*)(lds + LDSCTL_OFF))[u] = 0u;
    __syncthreads();
    XcdBarrier bar; bar.bar = (unsigned*)(ctl + CW_BAR); bar.x = 0; bar.st = nullptr;
    if (N_LAUNCHES == 1) bar = xcd_barrier_post((unsigned*)(ctl + CW_BAR), MISC + 8);
#define GRID_BAR() do { if (N_LAUNCHES == 1) xcd_barrier(bar); } while (0)
    const int lo = args.ph_lo, hi = args.ph_hi;
#ifndef PHASE_MASK
#define PHASE_MASK 0x3ff
#endif
#define IN(k) (((PHASE_MASK >> (k)) & 1) && lo <= (k) && (k) < hi)
#define BOTH(k) (IN(k) && IN((k) + 1))
#ifndef REPEAT_PHASE
#define REPEAT_PHASE -1
#endif
#define NREP(k) ((k) == REPEAT_PHASE ? 2 : 1)
#ifndef TS_PHASE
#define TS_PHASE -1
#endif
#ifndef TS_SCALE
#define TS_SCALE 1.0f
#endif
    unsigned long long ts_prev = 0ull, ts_val = 0ull; int ts_n = 0;
#ifndef CLK_PHASE
#define CLK_PHASE -1
#endif
    unsigned long long ck_prev = 0ull; float clk_val = 0.f;
    unsigned long long ts_first = 0ull;
#define STAMP() do { if (TS_PHASE >= 0) { const unsigned long long t_ = rt(); if (CLK_PHASE >= 0) { const unsigned long long c_ = __builtin_amdgcn_s_memtime(); if (ts_n == CLK_PHASE + 1) clk_val = (float)(c_ - ck_prev) / (float)(t_ - ts_prev) * 1.0f; ck_prev = c_; } if (ts_n == 0) ts_first = t_; if (ts_n == TS_PHASE + 1) ts_val = t_ - ts_prev; if (TS_PHASE == 99 && ts_n == 10) ts_val = t_ - ts_first; ts_prev = t_; ++ts_n; } } while (0)
    STAMP();
    const float* x = args.in[0];
    bf16* WIN = (bf16*)(ws + WS_WIN); bf16* WOUT = (bf16*)(ws + WS_WOUT); unsigned char* WGU = ws + WS_WGU; unsigned char* WD = ws + WS_WD;
    bf16* XN = (bf16*)(ws + WS_XN); bf16* T6 = (bf16*)(ws + WS_T6); bf16* MIX = (bf16*)(ws + WS_MIX);
    float* GATES = (float*)(ws + WS_GATES); float* KBIAS = (float*)(ws + WS_KBIAS); float* MST = (float*)(ws + WS_MST);
    unsigned char* rt_ = ws + WS_ROUTE;
    int* TOPI = (int*)(rt_ + RT_TOPI); float* TOPW = (float*)(rt_ + RT_TOPW); int* HIST = (int*)(rt_ + RT_HIST); int* POSSLOT = (int*)(rt_ + RT_POSSLOT);
    int* TOKPOS = (int*)(rt_ + RT_TOKPOS); float* GATEPOS = (float*)(rt_ + RT_GATEPOS); int* TILEPREF = (int*)(rt_ + RT_TILEPREF);
    unsigned char* ACT = ws + WS_ACT; unsigned char* Y = ws + WS_Y; bf16* X1B = (bf16*)(ws + WS_X1B);
    const MlArgs ML{T6 + 3 * (T6_STRIDE / 2), T6 + 4 * (T6_STRIDE / 2), T6 + 5 * (T6_STRIDE / 2), GATES, args.in[7], args.in[10], MST, MIX, KBIAS, (float*)(ws + WS_MPS)};

    if (IN(0)) { for (int rep_ = 0; rep_ < NREP(0); ++rep_) {
        PHASE_TID();
        const P0Args A{x, args.in[1], args.in[2], args.in[3], args.in[8], args.in[9], args.in[11], args.in[15], args.in[17], WIN, WOUT, WGU, WD, XN, GATES, KBIAS};
        p0_prologue(A, lds, vcu, G, tid, lane, wave);
        if (BOTH(0)) GRID_BAR();
        if (N_LAUNCHES == 1 && BOTH(0) && G % 8 == 0) {
            bool even = true;
            for (int j = 0; j < 16; ++j) { const unsigned cj = xb_ld(&bar.bar[XB_XCNT(j)]); even = even && (j < 8 ? cj == (unsigned)(G / 8) : cj == 0u); }
            if (even) { const int rk = (int)MISC[10], xx = (int)MISC[11]; vcu = xx * (G / 8) + rk; cvirt = rk * 8 + xx; }
        }
    } STAMP(); }
    if (IN(1)) { for (int rep_ = 0; rep_ < NREP(1); ++rep_) {
        pg8::Gemm g{XN, WIN, DMODEL, nullptr, nullptr, 0u}; pg8::StaticOrder S; S.init(MTOK, 3072, G, cvirt);
        pg8::EpiInProj E{T6, T6_STRIDE / 2, args.in[4], args.in[5]};
        pg8::gemm_phase<pg8::EpiInProj, pg8::StaticOrder, true, false>(lds, g, S, E);
        if (BOTH(1)) GRID_BAR();
    } STAMP(); }
    if (IN(2)) { for (int rep_ = 0; rep_ < NREP(2); ++rep_) {
        PHASE_TID();
        LAS unsigned char* wl = lds + wave * 17920;
        for (int it = vcu * NWAVES + wave; it < 2048 + 64; it += G * NWAVES) {
            if (it < 2048) ml_local_item(ML, it >> 5, it & 31, wl, lane);
            else fox_cumsum_item(ML, it - 2048, lane);
        }
        if (BOTH(2)) GRID_BAR();
    } STAMP(); }
    if (IN(3)) { for (int rep_ = 0; rep_ < NREP(3); ++rep_) {
        const attn_body::AttnTensors AT{(const attn_body::bf16*)T6, (const attn_body::bf16*)(T6 + T6_STRIDE / 2), (const attn_body::bf16*)(T6 + 2 * (T6_STRIDE / 2)), (attn_body::bf16*)MIX, KBIAS, args.in[6]};
        { PHASE_TID(); for (int it = vcu * NWAVES + wave; it < 64 * 33; it += G * NWAVES) ml_scan_item(ML, it / 33, it % 33, lane); }
        if (TS_PHASE == 31) { ts_val = rt() - ts_prev; }
        const attn_body::StaticOrder S(G, vcu);
        attn_body::attn_phase<attn_body::StaticOrder>((char*)lds_raw, AT, S);
        __syncthreads();
        if (TS_PHASE == 30) { ts_val = rt() - ts_prev; }
        GRID_BAR();
        if (TS_PHASE == 32) { ts_val = rt() - ts_prev; }
        PHASE_TID();
        LAS unsigned char* wl = lds + wave * ML_WL2;
        for (int v = vcu; v < 256; v += G) {
            const int pair = v & 15, bh = (v >> 4) * 4 + (wave >> 1), c = (wave & 1) ? 31 - pair : pair;
            ml_output_item_mfma(ML, bh, c, wl, lane, (TS_PHASE >= 60 && TS_PHASE <= 63 && blockIdx.x == 0 && wave == 0) ? (unsigned long long*)(ws + WS_CTL + 320 * 1024) : nullptr);
            if (TS_PHASE >= 60 && TS_PHASE <= 63 && blockIdx.x == 0) { __syncthreads(); ts_val = ((volatile unsigned long long*)(ws + WS_CTL + 320 * 1024))[TS_PHASE - 60]; }
        }
        if (BOTH(3)) GRID_BAR();
    } STAMP(); }
    if (IN(4)) { for (int rep_ = 0; rep_ < NREP(4); ++rep_) {
        pg8::Gemm g{MIX, WOUT, DMODEL, nullptr, nullptr, 0u}; pg8::StaticOrder S; S.init(MTOK, DMODEL, G, cvirt);
        pg8::EpiResid E{X1B, DMODEL};
        pg8::gemm_phase<pg8::EpiResid, pg8::StaticOrder, true, false>(lds, g, S, E);
        if (BOTH(4)) GRID_BAR();
    } STAMP(); }
    if (IN(5)) { for (int rep_ = 0; rep_ < NREP(5); ++rep_) {
        PHASE_TID();
        const RtArgs A{X1B, x, args.in[12], args.in[13], args.in[14], (unsigned char*)XN, TOPI, TOPW, HIST};
        p5_router(A, lds, vcu, G, tid, lane, wave, (TS_PHASE >= 50 && TS_PHASE <= 53 && blockIdx.x == 0) ? (unsigned long long*)(ws + WS_CTL + 300 * 1024) : nullptr);
        if (TS_PHASE >= 50 && TS_PHASE <= 53 && blockIdx.x == 0) { __syncthreads(); ts_val = ((volatile unsigned long long*)(ws + WS_CTL + 300 * 1024))[TS_PHASE - 50]; }
        if (BOTH(5)) GRID_BAR();
    } STAMP(); }
    if (IN(6)) { for (int rep_ = 0; rep_ < NREP(6); ++rep_) {
        PHASE_TID();
        const DsArgs A{TOPI, TOPW, HIST, POSSLOT, TOKPOS, GATEPOS, TILEPREF};
        p6_dispatch(A, lds, vcu, G, tid);
        if (BOTH(6)) GRID_BAR();
    } STAMP(); }
    if (IN(7)) { for (int rep_ = 0; rep_ < NREP(7); ++rep_) {
        pg8::Gemm g{XN, (const bf16*)WGU, DMODEL / 2, TOKPOS, nullptr, 0u}; if (TS_PHASE == 70) g.tprobe = (unsigned long long*)(ws + WS_CTL + 200 * 1024) + blockIdx.x; pg8::MoeOrder S; S.init(TILEPREF, 8, G, cvirt, 0, (volatile LAS int*)(MISC + 16)); __syncthreads();
        pg8::EpiSwiGLU E{ACT, args.in[16], (unsigned*)(ctl + CW_MOE)};
#ifdef STAGGER_NS
        { const int cc_ = (G % 8 == 0) ? (cvirt % 8) * (G / 8) + cvirt / 8 : cvirt; const unsigned long long t0_ = rt(), dl_ = (unsigned long long)(cc_ % 8) * (STAGGER_NS / 10); while (rt() - t0_ < dl_) __builtin_amdgcn_s_sleep(1); }
#endif
        pg8::gemm_phase<pg8::EpiSwiGLU, pg8::MoeOrder, true, true, true>(lds, g, S, E);
        if (TS_PHASE == 70) { __syncthreads(); ts_val = *((volatile unsigned long long*)(ws + WS_CTL + 200 * 1024) + blockIdx.x); }
    } STAMP(); }
    if (IN(8)) { for (int rep_ = 0; rep_ < NREP(8); ++rep_) {
        pg8::Gemm g{(const bf16*)ACT, (const bf16*)WD, DE / 2, nullptr, (const unsigned*)(ctl + CW_MOE), 64u}; pg8::MoeOrder S; S.init(TILEPREF, 4, G, cvirt, 1, (volatile LAS int*)(MISC + 16)); __syncthreads();
        pg8::EpiDown E{Y, args.in[18], GATEPOS};
        pg8::gemm_phase<pg8::EpiDown, pg8::MoeOrder, true, false, true, true>(lds, g, S, E);
        if (BOTH(8)) GRID_BAR();
    } STAMP(); }
    if (IN(9)) { PHASE_TID(); p9_combine(args.out, X1B, Y, POSSLOT, vcu, G, lane, wave); }
    if (TS_PHASE == 80) {
        GRID_BAR();
        if (blockIdx.x == 0 && wave == 0) {
            typedef int i32x8_ __attribute__((ext_vector_type(8))); typedef short bf16x8_ __attribute__((ext_vector_type(8)));
            f32x4 c0 = {0, 0, 0, 0}, c1 = c0, c2 = c0, c3 = c0; i32x8_ a8; bf16x8_ a4; int sw = 0x7F7F7F7F;
            for (int i = 0; i < 8; ++i) { a8[i] = 0x38383838; a4[i] = 0x3f80; } asm volatile("" : "+v"(a8), "+v"(a4), "+v"(sw));
            const unsigned long long t0 = __builtin_amdgcn_s_memtime();
            for (int i = 0; i < 256; ++i) {
                asm volatile("v_mfma_f32_16x16x32_bf16 %0, %4, %4, %0\n\tv_mfma_f32_16x16x32_bf16 %1, %4, %4, %1\n\tv_mfma_f32_16x16x32_bf16 %2, %4, %4, %2\n\tv_mfma_f32_16x16x32_bf16 %3, %4, %4, %3" : "+v"(c0), "+v"(c1), "+v"(c2), "+v"(c3) : "v"(a4)); }
            asm volatile("s_nop 15\n\ts_nop 15" ::: "memory");
            const unsigned long long t1 = __builtin_amdgcn_s_memtime();
            for (int i = 0; i < 256; ++i) {
                asm volatile("v_mfma_scale_f32_16x16x128_f8f6f4 %0, %4, %4, %0, %5, %5 op_sel_hi:[0,0,0]\n\tv_mfma_scale_f32_16x16x128_f8f6f4 %1, %4, %4, %1, %5, %5 op_sel_hi:[0,0,0]\n\tv_mfma_scale_f32_16x16x128_f8f6f4 %2, %4, %4, %2, %5, %5 op_sel_hi:[0,0,0]\n\tv_mfma_scale_f32_16x16x128_f8f6f4 %3, %4, %4, %3, %5, %5 op_sel_hi:[0,0,0]" : "+v"(c0), "+v"(c1), "+v"(c2), "+v"(c3) : "v"(a8), "v"(sw)); }
            asm volatile("s_nop 15\n\ts_nop 15" ::: "memory");
            const unsigned long long t2 = __builtin_amdgcn_s_memtime();
            asm volatile("" :: "v"(c0), "v"(c1), "v"(c2), "v"(c3));
            if (tid0 == 0) args.out[0] += 10.0f * (float)(t2 - t1) / (float)(t1 - t0);
        }
    }
    if (TS_PHASE >= 0 && TS_PHASE != 80) { GRID_BAR(); STAMP(); if (blockIdx.x == 0 && tid0 == 0) args.out[0] += (CLK_PHASE >= 0) ? clk_val : (float)ts_val * 0.01f * TS_SCALE; }
#undef IN
#undef BOTH
#undef GRID_BAR
}

extern "C" void kernel_launch(void* const* d_in, const int* in_sizes, int n_in, void* d_out, int out_size, void* d_ws, size_t ws_size, hipStream_t stream) {
    static int grid = 0;
    if (grid == 0) {
        if (n_in != 19 || in_sizes[0] != MTOK * DMODEL || out_size != MTOK * DMODEL || ws_size < WS_END) { fprintf(stderr, "kernel_launch: unexpected shapes (n_in %d, in0 %d, out %d, ws %zu); nothing launched\n", n_in, n_in > 0 ? in_sizes[0] : -1, out_size, ws_size); grid = -1; return; }
        int dev = 0, cus = 0, per_cu = 0;
        if (hipGetDevice(&dev) != hipSuccess || hipDeviceGetAttribute(&cus, hipDeviceAttributeMultiprocessorCount, dev) != hipSuccess) { grid = -1; return; }
        if (hipFuncSetAttribute((const void*)hymba_fwd, hipFuncAttributeMaxDynamicSharedMemorySize, LDS_BYTES) != hipSuccess) { fprintf(stderr, "kernel_launch: hipFuncSetAttribute failed\n"); grid = -1; return; }
        if (hipOccupancyMaxActiveBlocksPerMultiprocessor(&per_cu, (const void*)hymba_fwd, NWAVES * 64, LDS_BYTES) != hipSuccess || per_cu < 1) { fprintf(stderr, "kernel_launch: occupancy query reports %d workgroups per CU; nothing launched\n", per_cu); (void)hipGetLastError(); grid = -1; return; }
        (void)hipGetLastError();
        grid = cus;
    }
    if (grid < 0) return;
    if (hipMemsetAsync((char*)d_ws + WS_CTL, 0, CTL_ZERO_BYTES, stream) != hipSuccess) return;
    Args a{};
    for (int i = 0; i < 19; ++i) a.in[i] = (const float*)d_in[i];
    a.out = (float*)d_out; a.ws = (unsigned char*)d_ws;
    for (int li = 0; li < N_LAUNCHES; ++li) {
        a.ph_lo = (N_LAUNCHES == 1) ? 0 : li; a.ph_hi = (N_LAUNCHES == 1) ? N_PHASES : li + 1; a.li = li;
        hipLaunchKernelGGL(hymba_fwd, dim3(grid), dim3(NWAVES * 64), LDS_BYTES, stream, a);
        const hipError_t le = hipPeekAtLastError();
        if (le != hipSuccess) { fprintf(stderr, "kernel_launch: launch %d failed: %s\n", li, hipGetErrorName(le)); break; }
    }
}
```

```cpp
#include <hip/hip_runtime.h>
#include <hip/hip_bf16.h>
#include <cstdio>
#include <cstdint>
#include <cmath>

constexpr int BATCH = 8, SEQ = 2048, DMODEL = 1024, MTOK = BATCH * SEQ;
constexpr int FH = 8, HD = 64, MH = 8, MQKD = 32, MVD = 64;
constexpr int INW = 3096;
constexpr int NE = 32, TOPK = 4, DE = 1024;
constexpr int NSLOT = MTOK * TOPK;
constexpr int MAXPOS = NSLOT + NE * 256;
constexpr float NORM_EPS = 1e-5f;
constexpr float LOG2E = 1.4426950408889634f;
constexpr float QSCALE = 0.125f * LOG2E;

namespace pg8 {
#define PG8_LAS __attribute__((address_space(3)))
typedef unsigned short bf16_t;
typedef short bf16x8 __attribute__((ext_vector_type(8)));
typedef float f32x4 __attribute__((ext_vector_type(4)));
typedef unsigned u32x4 __attribute__((ext_vector_type(4)));
typedef unsigned u32x2 __attribute__((ext_vector_type(2)));
typedef int i32x4 __attribute__((ext_vector_type(4)));
typedef int i32x8 __attribute__((ext_vector_type(8)));
constexpr int BM = 256, BK = 64, HALF = 128, HTB = HALF * BK * 2  , STAGE_BYTES = 8 * HTB, NXCD = 8, WGM = 8;

__host__ __device__ __forceinline__ int lds_byte(int r, int c) { const int st = (r >> 4) * 2 + (c >> 5), rr = r & 15, cc = c & 31, ob = rr * 64 + cc * 2; return st * 1024 + (ob ^ (((ob >> 9) & 1) << 5)); }
__host__ __device__ __forceinline__ void stage_rc(int b, int& R, int& C) { const int st = b / 1024, sb = b % 1024, swz = sb ^ (((sb >> 9) & 1) << 5); R = (st >> 1) * 16 + swz / 64; C = (st & 1) * 32 + (swz % 64) / 2; }
__host__ __device__ __forceinline__ int perm32(int rho) { const int n = rho >> 4, i = rho & 15; return 8 * (i >> 2) + 4 * n + (i & 3); }

struct Unit { int pm, pn; };
struct Gemm { const bf16_t* A; const bf16_t* Bt; int K; const int* rowidx; const unsigned* ready; unsigned need; unsigned long long* tprobe = nullptr; };

struct StaticOrder {
    int nM, nN, nwg, G, c;
    __host__ __device__ void init(int M, int N, int G_, int c_) { nM = M / BM; nN = N / BM; nwg = nM * nN; G = G_; c = c_; }
    __host__ __device__ bool next(int i, Unit& u) const {
        const long L = (long)i * G + c; if (L >= nwg) return false;
        int wgid = (int)L; { const int q = nwg / NXCD, r = nwg % NXCD, xcd = wgid % NXCD, off = wgid / NXCD; wgid = (xcd < r ? xcd * (q + 1) : r * (q + 1) + (xcd - r) * q) + off; }
        const int nig = WGM * nN, gid = wgid / nig, fm = gid * WGM, gsz = (nM - fm) < WGM ? (nM - fm) : WGM;
        u.pm = fm + ((wgid % nig) % gsz); u.pn = (wgid % nig) / gsz; return true;
    }
};
struct MoeOrder {
    volatile PG8_LAS int* tb; int npn, nb, rank, total, off, r0;
    __device__ void init(const int* tp_, int npn_, int G_, int c_, int isdown, volatile PG8_LAS int* tb_) { tb = tb_; npn = npn_; const int cc = (G_ % 8 == 0) ? (c_ % 8) * (G_ / 8) + c_ / 8 : c_;
        nb = G_ / 8; const int x = cc / nb; rank = cc % nb; int cum = 0;
        for (int j = 0; j < 4; ++j) { const int e = tp_[33 + x + 8 * j], t0 = tp_[e], m = tp_[e + 1] - t0; cum += m; if (threadIdx.x == 0) { tb_[j] = e; tb_[4 + j] = t0; tb_[8 + j] = cum; } }
        total = cum * npn_; off = isdown ? 8 * cum : 0;
        r0 = (off > rank) ? (off - rank + nb - 1) / nb : 0; }
    __device__ bool next(int i, Unit& u) const {
        const int U = (r0 + i) * nb + rank - off; if (U >= total) return false;
        const int c1 = tb[8] * npn, c2 = tb[9] * npn, c3 = tb[10] * npn;
        const int j = (U >= c3) ? 3 : (U >= c2) ? 2 : (U >= c1) ? 1 : 0, base = j == 3 ? c3 : (j == 2 ? c2 : (j == 1 ? c1 : 0));
        const int e = tb[j], w = U - base;
        u.pm = tb[4 + j] + (w / npn); u.pn = e * npn + (w % npn); return true;
    }
};

__device__ __forceinline__ unsigned cvt_pk_bf16(float lo, float hi) { unsigned r; asm volatile("v_cvt_pk_bf16_f32 %0, %1, %2" : "=v"(r) : "v"(lo), "v"(hi)); return r; }

struct EpiInProj {
    static constexpr bool PERM = true;
    bf16_t* base; size_t tstride; const float* wq; const float* wk; unsigned* done;
    __device__ __forceinline__ void operator()(const f32x4 (&acc)[2][2][4][2], const Unit& u, int wr, int wc, int fr, int fq) const {
        const int tt = u.pn >> 1, row0 = u.pm * BM + wr * 64 + fr, colb = (u.pn & 1) * 256 + 64 * wc + 8 * fq;
        bf16_t* T = base + (size_t)tt * tstride;
        if (tt <= 1) {
            const float* w = tt == 0 ? wq : wk; const float sc = tt == 0 ? QSCALE : 1.0f;
            f32x4 wv[2][2];
#pragma unroll
            for (int bj = 0; bj < 2; ++bj)
#pragma unroll
                for (int n = 0; n < 2; ++n) wv[bj][n] = *(const f32x4*)(w + 32 * bj + 8 * fq + 4 * n) * sc;
#pragma unroll
            for (int ai = 0; ai < 2; ++ai)
#pragma unroll
                for (int m = 0; m < 4; ++m) {
                    float ss = 0.f;
#pragma unroll
                    for (int bj = 0; bj < 2; ++bj)
#pragma unroll
                        for (int n = 0; n < 2; ++n) { const f32x4 x = acc[ai][bj][m][n]; ss += (x[0] * x[0] + x[1] * x[1]) + (x[2] * x[2] + x[3] * x[3]); }
                    ss += __shfl_xor(ss, 16); ss += __shfl_xor(ss, 32);
                    const float rstd = 1.0f / sqrtf(ss * (1.0f / 64.0f) + NORM_EPS);
                    bf16_t* rowp = T + (size_t)(row0 + ai * HALF + m * 16) * 512 + colb;
#pragma unroll
                    for (int bj = 0; bj < 2; ++bj) { const f32x4 v0 = acc[ai][bj][m][0] * rstd * wv[bj][0], v1 = acc[ai][bj][m][1] * rstd * wv[bj][1];
                        u32x4 o; o.x = cvt_pk_bf16(v0[0], v0[1]); o.y = cvt_pk_bf16(v0[2], v0[3]); o.z = cvt_pk_bf16(v1[0], v1[1]); o.w = cvt_pk_bf16(v1[2], v1[3]);
                        *(u32x4*)(rowp + 32 * bj) = o; }
                }
        } else {
#pragma unroll
            for (int ai = 0; ai < 2; ++ai)
#pragma unroll
                for (int m = 0; m < 4; ++m) { bf16_t* rowp = T + (size_t)(row0 + ai * HALF + m * 16) * 512 + colb;
#pragma unroll
                    for (int bj = 0; bj < 2; ++bj) { const f32x4 v0 = acc[ai][bj][m][0], v1 = acc[ai][bj][m][1];
                        u32x4 o; o.x = cvt_pk_bf16(v0[0], v0[1]); o.y = cvt_pk_bf16(v0[2], v0[3]); o.z = cvt_pk_bf16(v1[0], v1[1]); o.w = cvt_pk_bf16(v1[2], v1[3]);
                        *(u32x4*)(rowp + 32 * bj) = o; } }
        }
        if (done) { asm volatile("s_waitcnt vmcnt(0)" ::: "memory"); if (fr == 0 && fq == 0) __hip_atomic_fetch_add(done + 32 * u.pm, 1u, __ATOMIC_RELAXED, __HIP_MEMORY_SCOPE_AGENT); }
    }
};
struct EpiResid {
    static constexpr bool PERM = true;
    bf16_t* out; int ldc; unsigned* done;
    __device__ __forceinline__ void operator()(const f32x4 (&acc)[2][2][4][2], const Unit& u, int wr, int wc, int fr, int fq) const {
        const int row0 = u.pm * BM + wr * 64 + fr, col0 = u.pn * BM + wc * 32 + 8 * fq;
#pragma unroll
        for (int ai = 0; ai < 2; ++ai)
#pragma unroll
            for (int m = 0; m < 4; ++m) { const size_t off = (size_t)(row0 + ai * HALF + m * 16) * ldc + col0;
#pragma unroll
                for (int bj = 0; bj < 2; ++bj) { const f32x4 v0 = acc[ai][bj][m][0], v1 = acc[ai][bj][m][1];
                    u32x4 o; o.x = cvt_pk_bf16(v0[0], v0[1]); o.y = cvt_pk_bf16(v0[2], v0[3]); o.z = cvt_pk_bf16(v1[0], v1[1]); o.w = cvt_pk_bf16(v1[2], v1[3]);
                    *(u32x4*)(out + off + bj * HALF) = o; } }
        if (done) { asm volatile("s_waitcnt vmcnt(0)" ::: "memory"); if (fr == 0 && fq == 0) __hip_atomic_fetch_add(done + 64 * u.pm, 1u, __ATOMIC_RELAXED, __HIP_MEMORY_SCOPE_AGENT); }
    }
};
typedef float f32x2e __attribute__((ext_vector_type(2)));
__device__ __forceinline__ f32x2e swiglu2(f32x2e ga, f32x2e ua) {
    const f32x2e g2 = {fminf(ga.x, 7.0f), fminf(ga.y, 7.0f)}, u2 = {fminf(fmaxf(ua.x, -7.0f), 7.0f), fminf(fmaxf(ua.y, -7.0f), 7.0f)};
    const f32x2e t2 = g2 * (f32x2e){-1.702f * LOG2E, -1.702f * LOG2E};
    const f32x2e d2 = (f32x2e){__builtin_amdgcn_exp2f(t2.x), __builtin_amdgcn_exp2f(t2.y)} + (f32x2e){1.0f, 1.0f};
    const f32x2e s2 = {__builtin_amdgcn_rcpf(d2.x), __builtin_amdgcn_rcpf(d2.y)};
    return (u2 + (f32x2e){1.0f, 1.0f}) * (g2 * s2);
}
struct EpiSwiGLU {
    static constexpr bool PERM = true;
    unsigned char* act; const float* bgu; unsigned* done; bool wt;
    __device__ __forceinline__ void operator()(const f32x4 (&acc)[2][2][4][2], const Unit& u, int wr, int wc, int fr, int fq) const {
        const int e = u.pn >> 3, pnl = u.pn & 7, row0 = u.pm * BM + wr * 64 + fr, colg = 128 * pnl + 32 * wc + 8 * fq;
        f32x4 bg[2], bu[2];
#pragma unroll
        for (int n = 0; n < 2; ++n) { bg[n] = *(const f32x4*)(bgu + (size_t)e * 2048 + colg + 4 * n); bu[n] = *(const f32x4*)(bgu + (size_t)e * 2048 + 1024 + colg + 4 * n); }
#pragma unroll
        for (int ai = 0; ai < 2; ++ai)
#pragma unroll
            for (int m = 0; m < 4; ++m) {
                unsigned w[2];
#pragma unroll
                for (int n = 0; n < 2; ++n) {
                    const f32x4 gq = acc[ai][0][m][n], uq = acc[ai][1][m][n];
                    const f32x2e r2[2] = { swiglu2(__builtin_shufflevector(gq, gq, 0, 1) + __builtin_shufflevector(bg[n], bg[n], 0, 1), __builtin_shufflevector(uq, uq, 0, 1) + __builtin_shufflevector(bu[n], bu[n], 0, 1)),
                                           swiglu2(__builtin_shufflevector(gq, gq, 2, 3) + __builtin_shufflevector(bg[n], bg[n], 2, 3), __builtin_shufflevector(uq, uq, 2, 3) + __builtin_shufflevector(bu[n], bu[n], 2, 3)) };
                    int pk = __builtin_amdgcn_cvt_pk_fp8_f32(r2[0].x, r2[0].y, 0, false); pk = __builtin_amdgcn_cvt_pk_fp8_f32(r2[1].x, r2[1].y, pk, true); w[n] = (unsigned)pk; }
                unsigned long long* ap = (unsigned long long*)(act + (size_t)(row0 + ai * HALF + m * 16) * DE + colg); const unsigned long long av = (unsigned long long)w[0] | ((unsigned long long)w[1] << 32);
                if (wt) __hip_atomic_store(ap, av, __ATOMIC_RELAXED, __HIP_MEMORY_SCOPE_AGENT); else *ap = av;
            }
        asm volatile("s_waitcnt vmcnt(0)" ::: "memory");
        if (fr == 0 && fq == 0) __hip_atomic_fetch_add(done + 64 * u.pm, 1u, __ATOMIC_RELAXED, __HIP_MEMORY_SCOPE_AGENT);
    }
};
struct EpiDown {
    static constexpr bool PERM = true;
    unsigned char* y; const float* bd; const float* gate;
    __device__ __forceinline__ void operator()(const f32x4 (&acc)[2][2][4][2], const Unit& u, int wr, int wc, int fr, int fq) const {
        const int e = u.pn >> 2, pnl = u.pn & 3, row0 = u.pm * BM + wr * 64 + fr, col0 = 256 * pnl + 32 * wc + 8 * fq;
        f32x4 bv[2][2];
#pragma unroll
        for (int bj = 0; bj < 2; ++bj)
#pragma unroll
            for (int n = 0; n < 2; ++n) bv[bj][n] = *(const f32x4*)(bd + (size_t)e * DMODEL + col0 + bj * HALF + 4 * n);
#pragma unroll
        for (int ai = 0; ai < 2; ++ai)
#pragma unroll
            for (int m = 0; m < 4; ++m) { const int row = row0 + ai * HALF + m * 16; const float gw = gate[row]; unsigned char* rowp = y + (size_t)row * DMODEL + col0;
#pragma unroll
                for (int bj = 0; bj < 2; ++bj) { const f32x4 v0 = (acc[ai][bj][m][0] + bv[bj][0]) * gw, v1 = (acc[ai][bj][m][1] + bv[bj][1]) * gw;
                    int p0 = __builtin_amdgcn_cvt_pk_fp8_f32(v0[0], v0[1], 0, false); p0 = __builtin_amdgcn_cvt_pk_fp8_f32(v0[2], v0[3], p0, true);
                    int p1 = __builtin_amdgcn_cvt_pk_fp8_f32(v1[0], v1[1], 0, false); p1 = __builtin_amdgcn_cvt_pk_fp8_f32(v1[2], v1[3], p1, true);
                    u32x2 o; o.x = (unsigned)p0; o.y = (unsigned)p1; *(u32x2*)(rowp + bj * HALF) = o; } }
    }
};

constexpr int F8_SCALE_W = 0x7A7A7A7A, F8_SCALE_X = 0x7F7F7F7F;
template <class Epi, class Sched, bool ALIGN_EPI, bool GATHER, bool FP8 = false, bool DEP = false>
__device__ __forceinline__ void gemm_phase(PG8_LAS unsigned char* lds, const Gemm g, const Sched& S, const Epi& E) {
    const int tid = threadIdx.x, wid = __builtin_amdgcn_readfirstlane(tid >> 6), lane = tid & 63, wr = wid >> 2, wc = wid & 3, fr = lane & 15, fq = lane >> 4;
    const int K = g.K, nt = K / BK;
    unsigned voffA[2], voffB[2]; int RA[2], CA[2];
#pragma unroll
    for (int i = 0; i < 2; ++i) { int R, C; stage_rc(tid * 16 + i * 8192, R, C); const int Rb = Epi::PERM ? ((R & ~31) + perm32(R & 31)) : R;
        RA[i] = R; CA[i] = C; voffA[i] = (unsigned)(R * K + C) * 2u; voffB[i] = (unsigned)(Rb * K + C) * 2u; }
    const size_t kstep = (size_t)(BK * 2);
    const size_t hstep = (size_t)HALF * K * 2;
    const size_t tstep = 2 * hstep;
    const unsigned ldsw = (unsigned)wid * 1024u;
    const int aoff = lds_byte(wr * 64 + fr, fq * 8), boff = lds_byte(wc * 32 + fr, fq * 8);
#define PG8_SA(b, h) (((b) * 2 + (h)) * HTB)
#define PG8_SB(b, h) ((4 + (b) * 2 + (h)) * HTB)
#define PG8_STAGE(bufoff, gbase, voff) do { _Pragma("unroll") for (int _i = 0; _i < 2; ++_i) \
        __builtin_amdgcn_global_load_lds((const unsigned*)((const char*)(gbase) + (voff)[_i]), (PG8_LAS unsigned*)(lds + (bufoff) + ldsw + _i * 8192), 16, 0, 0); } while (0)
#define PG8_STAGE_A(bufoff, p, h, vg) do { if constexpr (GATHER) { PG8_STAGE(bufoff, p, (vg)[h]); } else { PG8_STAGE(bufoff, (p) + (h) * hstep, voffA); } } while (0)
#define PG8_LD8(p_) __builtin_shufflevector(*(const PG8_LAS i32x4*)(p_), *(const PG8_LAS i32x4*)((p_) + 1024), 0, 1, 2, 3, 4, 5, 6, 7)
#define PG8_LDA(dst, b, h) do { if constexpr (FP8) { _Pragma("unroll") for (int m = 0; m < 4; ++m) dst##8[m] = PG8_LD8(lds + PG8_SA(b, h) + aoff + m * 2048); } else { \
        _Pragma("unroll") for (int m = 0; m < 4; ++m) _Pragma("unroll") for (int k = 0; k < 2; ++k) dst[m][k] = *(const PG8_LAS bf16x8*)(lds + PG8_SA(b, h) + aoff + m * 2048 + k * 1024); } } while (0)
#define PG8_LDB(dst, b, h) do { if constexpr (FP8) { _Pragma("unroll") for (int n = 0; n < 2; ++n) dst##8[n] = PG8_LD8(lds + PG8_SB(b, h) + boff + n * 2048); } else { \
        _Pragma("unroll") for (int n = 0; n < 2; ++n) _Pragma("unroll") for (int k = 0; k < 2; ++k) dst[n][k] = *(const PG8_LAS bf16x8*)(lds + PG8_SB(b, h) + boff + n * 2048 + k * 1024); } } while (0)
#define PG8_MMA(ai, bj, At, Bt) do { __builtin_amdgcn_s_setprio(1); if constexpr (FP8) { _Pragma("unroll") for (int m = 0; m < 4; ++m) _Pragma("unroll") for (int n = 0; n < 2; ++n) \
        asm volatile("v_mfma_scale_f32_16x16x128_f8f6f4 %0, %1, %2, %0, %3, %4 op_sel_hi:[0,0,0]" : "+v"(acc[ai][bj][m][n]) : "v"(Bt##8[n]), "v"(At##8[m]), "v"(f8sw), "v"(f8sx)); } else { \
        _Pragma("unroll") for (int m = 0; m < 4; ++m) _Pragma("unroll") for (int n = 0; n < 2; ++n) _Pragma("unroll") for (int k = 0; k < 2; ++k) \
        acc[ai][bj][m][n] = __builtin_amdgcn_mfma_f32_16x16x32_bf16(Bt[n][k], At[m][k], acc[ai][bj][m][n], 0, 0, 0); } __builtin_amdgcn_s_setprio(0); } while (0)
#define PG8_WAIT_V(n) asm volatile("s_waitcnt vmcnt(" #n ")" ::: "memory")
#define PG8_WAIT_L(n) asm volatile("s_waitcnt lgkmcnt(" #n ")" ::: "memory")
#define PG8_BAR __builtin_amdgcn_s_barrier()
#define PG8_SCHED __builtin_amdgcn_sched_barrier(0)
    Unit cur, nxt; int ui = 0; unsigned long long epi_t_ = 0ull;
    if (!S.next(0, cur)) return;
#define PG8_PEEK(pm_) ((unsigned)__builtin_amdgcn_readfirstlane((int)__hip_atomic_load(g.ready + 64 * (pm_), __ATOMIC_RELAXED, __HIP_MEMORY_SCOPE_AGENT)))
#define PG8_WAIT_READY(pm_) do { unsigned sp_ = 0; while (PG8_PEEK(pm_) < g.need && ++sp_ < (1u << 22)) __builtin_amdgcn_s_sleep(2); } while (0)
    if constexpr (DEP) PG8_WAIT_READY(cur.pm);
    f32x4 acc[2][2][4][2];
#pragma unroll
    for (int a = 0; a < 2; ++a)
#pragma unroll
        for (int b = 0; b < 2; ++b)
#pragma unroll
            for (int m = 0; m < 4; ++m)
#pragma unroll
                for (int n = 0; n < 2; ++n) acc[a][b][m][n] = (f32x4){0.f, 0.f, 0.f, 0.f};
    bf16x8 At[4][2], B0[2][2], B1[2][2];
    i32x8 At8[4], B08[2], B18[2];
    int f8sw = F8_SCALE_W, f8sx = F8_SCALE_X; asm volatile("" : "+v"(f8sw), "+v"(f8sx));
    unsigned vgC[2][2], vgN[2][2];
    if constexpr (GATHER) {
#pragma unroll
        for (int h = 0; h < 2; ++h)
#pragma unroll
            for (int i = 0; i < 2; ++i) { vgC[h][i] = ((unsigned)g.rowidx[cur.pm * BM + h * HALF + RA[i]] * (unsigned)K + (unsigned)CA[i]) * 2u; vgN[h][i] = vgC[h][i]; }
    }
    const char* cA = GATHER ? (const char*)g.A : (const char*)g.A + (size_t)cur.pm * tstep; const char* cB = (const char*)g.Bt + (size_t)cur.pn * tstep;
    PG8_STAGE(PG8_SB(0, 0), cB, voffB); PG8_STAGE(PG8_SB(0, 1), cB + hstep, voffB); PG8_STAGE_A(PG8_SA(0, 0), cA, 0, vgC); PG8_STAGE_A(PG8_SA(0, 1), cA, 1, vgC);
    if (wr == 1) PG8_BAR;
    PG8_WAIT_V(2); PG8_BAR;
    PG8_STAGE(PG8_SB(1, 0), cB + kstep, voffB); PG8_STAGE_A(PG8_SA(1, 0), cA + kstep, 0, vgC); PG8_STAGE(PG8_SB(1, 1), cB + hstep + kstep, voffB);
    PG8_WAIT_V(6); PG8_BAR;
    for (;;) {
        const bool has_next = S.next(ui + 1, nxt);
        unsigned peek = 0u; if constexpr (DEP) { if (has_next) peek = PG8_PEEK(nxt.pm); }
        if constexpr (GATHER) { if (has_next) {
#pragma unroll
            for (int h = 0; h < 2; ++h)
#pragma unroll
                for (int i = 0; i < 2; ++i) vgN[h][i] = ((unsigned)g.rowidx[nxt.pm * BM + h * HALF + RA[i]] * (unsigned)K + (unsigned)CA[i]) * 2u; } }
        const char* nA = GATHER ? cA : (has_next ? (const char*)g.A + (size_t)nxt.pm * tstep : cA); const char* nB = has_next ? (const char*)g.Bt + (size_t)nxt.pn * tstep : cB;
        for (int t = 0; t < nt; t += 2) {
            const bool last = (t == nt - 2);
            if constexpr (DEP) { if (last && has_next && peek < g.need) PG8_WAIT_READY(nxt.pm); }
            const char* a1 = cA + (size_t)(t + 1) * kstep;
            const char* a2 = last ? nA : cA + (size_t)(t + 2) * kstep; const char* b2 = last ? nB : cB + (size_t)(t + 2) * kstep;
            const char* a3 = a2 + kstep; const char* b3 = b2 + kstep;
            unsigned vg2[2][2];
            if constexpr (GATHER) {
#pragma unroll
                for (int h = 0; h < 2; ++h)
#pragma unroll
                    for (int i = 0; i < 2; ++i) vg2[h][i] = last ? vgN[h][i] : vgC[h][i];
            }
            PG8_LDB(B0, 0, 0); PG8_LDB(B1, 0, 1); PG8_SCHED; PG8_LDA(At, 0, 0); PG8_STAGE_A(PG8_SA(1, 1), a1, 1, vgC);
            PG8_WAIT_V(8); PG8_WAIT_L(0); PG8_BAR; PG8_MMA(0, 0, At, B0); PG8_MMA(0, 1, At, B1); PG8_BAR; PG8_SCHED;
            PG8_LDA(At, 0, 1); PG8_STAGE(PG8_SB(0, 0), b2, voffB); PG8_STAGE(PG8_SB(0, 1), b2 + hstep, voffB); PG8_STAGE_A(PG8_SA(0, 0), a2, 0, vg2);
            PG8_WAIT_V(8); PG8_WAIT_L(0); PG8_BAR; PG8_MMA(1, 0, At, B0); PG8_MMA(1, 1, At, B1); PG8_BAR; PG8_SCHED;
            PG8_LDB(B0, 1, 0); PG8_LDB(B1, 1, 1); PG8_SCHED; PG8_LDA(At, 1, 0); PG8_STAGE_A(PG8_SA(0, 1), a2, 1, vg2);
            PG8_WAIT_V(8); PG8_WAIT_L(0); PG8_BAR; PG8_MMA(0, 0, At, B0); PG8_MMA(0, 1, At, B1); PG8_BAR; PG8_SCHED;
            PG8_LDA(At, 1, 1); PG8_STAGE(PG8_SB(1, 0), b3, voffB); PG8_STAGE(PG8_SB(1, 1), b3 + hstep, voffB); PG8_STAGE_A(PG8_SA(1, 0), a3, 0, vg2);
            PG8_WAIT_V(8); PG8_WAIT_L(0); PG8_BAR; PG8_MMA(1, 0, At, B0); PG8_MMA(1, 1, At, B1); PG8_BAR; PG8_SCHED;
        }
        if constexpr (ALIGN_EPI) { if (wr == 0) PG8_BAR; }
        const unsigned long long te0_ = g.tprobe ? __builtin_amdgcn_s_memrealtime() : 0ull;
        if constexpr (FP8) asm volatile("s_nop 15\n\ts_nop 15" ::: "memory");
        E(acc, cur, wr, wc, fr, fq);
        if (g.tprobe) { asm volatile("s_waitcnt vmcnt(0)" ::: "memory"); epi_t_ += __builtin_amdgcn_s_memrealtime() - te0_; }
        if (!has_next) break;
#pragma unroll
        for (int a = 0; a < 2; ++a)
#pragma unroll
            for (int b = 0; b < 2; ++b)
#pragma unroll
                for (int m = 0; m < 4; ++m)
#pragma unroll
                    for (int n = 0; n < 2; ++n) acc[a][b][m][n] = (f32x4){0.f, 0.f, 0.f, 0.f};
        cur = nxt; cA = nA; cB = nB; ++ui;
        if constexpr (GATHER) {
#pragma unroll
            for (int h = 0; h < 2; ++h)
#pragma unroll
                for (int i = 0; i < 2; ++i) vgC[h][i] = vgN[h][i];
        }
        if constexpr (ALIGN_EPI) { if (wr == 1) PG8_BAR; }
    }
    PG8_WAIT_V(0);
    if constexpr (!ALIGN_EPI) { if (wr == 0) PG8_BAR; }
    PG8_BAR;
    if (g.tprobe && threadIdx.x == 0) *g.tprobe = epi_t_;
#undef PG8_PEEK
#undef PG8_WAIT_READY
#undef PG8_SA
#undef PG8_SB
#undef PG8_STAGE
#undef PG8_STAGE_A
#undef PG8_LDA
#undef PG8_LD8
#undef PG8_LDB
#undef PG8_MMA
#undef PG8_WAIT_V
#undef PG8_WAIT_L
#undef PG8_BAR
#undef PG8_SCHED
}
}
namespace attn_body {
using bf16=__hip_bfloat16;
using bf16x8=__attribute__((ext_vector_type(8)))short;
using s16x4=__attribute__((ext_vector_type(4)))short;
using f32x16=__attribute__((ext_vector_type(16)))float;
using u32x4=__attribute__((ext_vector_type(4)))unsigned;
typedef float f32x4_t __attribute__((ext_vector_type(4)));
constexpr int BATCH=8,NHEAD=8,SEQ=2048,D=64,DM=NHEAD*D,OPITCH=1024;
constexpr int NW=8,QBLK=32,QB=QBLK*NW,KVBLK=64,NQB=SEQ/QB;
static_assert(NQB==8,"static order assumes 8 query blocks per (b,h)");
__device__ __forceinline__ int crow(int r,int hi){return (r&3)+8*(r>>2)+4*hi;}
#define SBAR() __builtin_amdgcn_sched_barrier(0)
__device__ __forceinline__ void cmask(f32x16&p0,f32x16&p1,int jb,int qrel,int hi){
  const float NEG=-INFINITY; int kb=64*jb+4*hi;
  #pragma unroll
  for(int r=0;r<16;++r){int kv=kb+(r&3)+8*(r>>2); if(kv>qrel)p0[r]=NEG; if(kv+32>qrel)p1[r]=NEG;}
}

constexpr int NSLOT=3, SLOTB=8192;
constexpr int LDS_K=0, LDS_V=NSLOT*SLOTB, LDS_WS=2*NSLOT*SLOTB, LDS_OST=LDS_WS+NW*64*4, LDS_KB=LDS_OST+NW*4096, LDS_BYTES=LDS_KB+SEQ*4;
constexpr float C2=0.125f*1.4426950408889634f;
__device__ __forceinline__ void glds16(const void*gsrc,unsigned lds_dst){unsigned keep;
  asm volatile("s_mov_b32 %0, m0\n\ts_mov_b32 m0, %2\n\ts_nop 0\n\tglobal_load_lds_dwordx4 %1, off\n\ts_mov_b32 m0, %0":"=&s"(keep):"v"(gsrc),"s"(lds_dst):"memory");}
__device__ __forceinline__ float max3f(float a,float b,float c){float r;asm("v_max3_f32 %0, %1, %2, %3":"=v"(r):"v"(a),"v"(b),"v"(c));return r;}
__device__ __forceinline__ float max2f(float a,float b){float r;asm("v_max_f32_e32 %0, %1, %2":"=v"(r):"v"(a),"v"(b));return r;}
__device__ __forceinline__ float fadd_s(float a,float b){float r;asm("v_add_f32_e32 %0, %1, %2":"=v"(r):"v"(a),"v"(b));return r;}
__device__ __forceinline__ float fsub_s(float a,float b){float r;asm("v_sub_f32_e32 %0, %1, %2":"=v"(r):"v"(a),"v"(b));return r;}
typedef float f32x2_t __attribute__((ext_vector_type(2))); typedef __bf16 bf16x2_t __attribute__((ext_vector_type(2)));
__device__ __forceinline__ unsigned cvtpk_s(float lo,float hi){f32x2_t v={lo,hi};bf16x2_t b=__builtin_convertvector(v,bf16x2_t);return __builtin_bit_cast(unsigned,b);}
#define WAIT_BAR(N) asm volatile("s_waitcnt vmcnt(" #N ") lgkmcnt(0)\n\ts_barrier":::"memory")

__device__ __forceinline__ void qkt(f32x16&p0,f32x16&p1,const char*Kslot,const bf16x8*qr,int r32,int hi){
  const char*kb=Kslot+hi*1024+r32*16;
  #pragma unroll
  for(int d0=0;d0<4;++d0){
    const bf16x8 b0=*reinterpret_cast<const bf16x8*>(kb+d0*2048);
    const bf16x8 b1=*reinterpret_cast<const bf16x8*>(kb+d0*2048+512);
    {p0=__builtin_amdgcn_mfma_f32_32x32x16_bf16(b0,qr[d0],p0,0,0,0);p1=__builtin_amdgcn_mfma_f32_32x32x16_bf16(b1,qr[d0],p1,0,0,0);}}
}
typedef __attribute__((address_space(3))) const char* lds_cptr;
typedef short v4i16_t __attribute__((ext_vector_type(4)));
__device__ __forceinline__ void kload8(bf16x8*kf,lds_cptr kp){
  kf[0]=*(const __attribute__((address_space(3))) bf16x8*)(kp);      kf[1]=*(const __attribute__((address_space(3))) bf16x8*)(kp+512);
  kf[2]=*(const __attribute__((address_space(3))) bf16x8*)(kp+2048); kf[3]=*(const __attribute__((address_space(3))) bf16x8*)(kp+2560);
  kf[4]=*(const __attribute__((address_space(3))) bf16x8*)(kp+4096); kf[5]=*(const __attribute__((address_space(3))) bf16x8*)(kp+4608);
  kf[6]=*(const __attribute__((address_space(3))) bf16x8*)(kp+6144); kf[7]=*(const __attribute__((address_space(3))) bf16x8*)(kp+6656);
}
__device__ __forceinline__ void kload2(bf16x8*kf,lds_cptr kp,int j){ kf[2*j]=*(const __attribute__((address_space(3))) bf16x8*)(kp+j*2048); kf[2*j+1]=*(const __attribute__((address_space(3))) bf16x8*)(kp+j*2048+512); }
__device__ __forceinline__ s16x4 vtr(lds_cptr p){ return __builtin_bit_cast(s16x4,__builtin_amdgcn_ds_read_tr16_b64_v4i16((__attribute__((address_space(3))) v4i16_t*)p)); }
__device__ __forceinline__ float rowmax(const f32x16&p0,const f32x16&p1){
  float a=max3f(p0[0],p0[1],p1[0]),b=max3f(p0[2],p0[3],p1[1]);a=max3f(a,p1[2],p1[3]);
  #pragma unroll
  for(int r=4;r<16;r+=4){a=max3f(a,p0[r],p0[r+1]);b=max3f(b,p0[r+2],p0[r+3]);a=max3f(a,p1[r],p1[r+1]);b=max3f(b,p1[r+2],p1[r+3]);}
  const float m=max2f(a,b);
  auto rr=__builtin_amdgcn_permlane32_swap(__float_as_uint(m),__float_as_uint(m),false,false);
  return max2f(__uint_as_float(rr[0]),__uint_as_float(rr[1]));
}
__device__ __forceinline__ void pv(f32x16*o,int vb,bf16x8 pa0,bf16x8 pa1,bf16x8 pa2,bf16x8 pa3){
  #pragma unroll
  for(int d0=0;d0<2;++d0){s16x4 lo[4],hi[4];
    #pragma unroll
    for(int ks=0;ks<4;++ks){
      asm volatile("ds_read_b64_tr_b16 %0,%1 offset:%c2":"=&v"(lo[ks]):"v"(vb),"i"(d0*4096+ks*1024):"memory");
      asm volatile("ds_read_b64_tr_b16 %0,%1 offset:%c2":"=&v"(hi[ks]):"v"(vb),"i"(d0*4096+ks*1024+512):"memory");}
    asm volatile("s_waitcnt lgkmcnt(0)":::"memory");SBAR();
    #define PK(k) (bf16x8){lo[k][0],lo[k][1],lo[k][2],lo[k][3],hi[k][0],hi[k][1],hi[k][2],hi[k][3]}
    o[d0]=__builtin_amdgcn_mfma_f32_32x32x16_bf16(pa0,PK(0),o[d0],0,0,0);
    o[d0]=__builtin_amdgcn_mfma_f32_32x32x16_bf16(pa1,PK(1),o[d0],0,0,0);
    o[d0]=__builtin_amdgcn_mfma_f32_32x32x16_bf16(pa2,PK(2),o[d0],0,0,0);
    o[d0]=__builtin_amdgcn_mfma_f32_32x32x16_bf16(pa3,PK(3),o[d0],0,0,0);
    #undef PK
  }
}

#ifndef ATTN_STORE16
#define ATTN_STORE16(p,v) (*(u32x4*)(p)=(v))
#endif
template<int THRL> __device__ __forceinline__ void attn_unit(int b,int h,int qb,const bf16*Q,const bf16*__restrict__ K,const bf16*__restrict__ V,bf16*O,const float*kbias,const float*onw,char*shm){
  const int tid=threadIdx.x,lane=tid&63,r32=lane&31,hi=lane>>5; const int wid=__builtin_amdgcn_readfirstlane(tid>>6);
  const long rowbase=(long)b*SEQ; const int q0=qb*QB;
  const bf16*Qw=Q+(rowbase+q0+wid*QBLK)*DM+h*D;
  const bf16*Kh=K+rowbase*DM+h*D,*Vh=V+rowbase*DM+h*D;
  const unsigned lds0=(unsigned)(uintptr_t)shm;
  float*wsf=(float*)(shm+LDS_WS)+wid*64;
  const bf16*ksrc=Kh+(long)lane*DM+wid*8;
  const bf16*vsrc=Vh+(long)(16*(wid&3)+(lane>>2))*DM+(wid>>2)*32+(lane&3)*8;
  const unsigned kdst=lds0+LDS_K+wid*1024, vdst=lds0+LDS_V+wid*1024;
  #define DMA_K(t,slot) glds16(ksrc+(long)(t)*KVBLK*DM,(unsigned)__builtin_amdgcn_readfirstlane(kdst+(slot)))
  #define DMA_V(t,slot) glds16(vsrc+(long)(t)*KVBLK*DM,(unsigned)__builtin_amdgcn_readfirstlane(vdst+(slot)))
  const int vb0=(int)(lds0+LDS_V)+((lane>>4)&1)*32+(lane&3)*8+(4*hi+((lane&15)>>2))*64;
  const char*Kbase=shm+LDS_K; bf16x8 kf[8];
  const lds_cptr shm3=(lds_cptr)shm; const lds_cptr kp0=shm3+LDS_K+hi*1024+r32*16; const lds_cptr vp0=shm3+LDS_V+((lane>>4)&1)*32+(lane&3)*8+(4*hi+((lane&15)>>2))*64;
  const int NT=(q0+QB)/KVBLK;
  { const float*kbg=kbias+(long)(b*NHEAD+h)*SEQ;
    if(tid*4<NT*KVBLK){ const f32x4_t kv4=*(const f32x4_t*)(kbg+tid*4); *(__attribute__((address_space(3))) f32x4_t*)(shm3+LDS_KB+tid*16)=kv4; } }
  DMA_K(0,0);DMA_V(0,0);DMA_K(1,SLOTB);
  bf16x8 qr[4];
  #pragma unroll
  for(int d0=0;d0<4;++d0)qr[d0]=*reinterpret_cast<const bf16x8*>(&Qw[(long)r32*DM+d0*16+hi*8]);
  float mhat=0.f,l_reg=0.f;f32x16 o[2];o[0]=f32x16{};o[1]=f32x16{};
  const int qrel=wid*QBLK+r32;
  #define CMASK(P0,P1,t) do{int jb_=(t)-(NT-4); if(jb_>=0)cmask(P0,P1,jb_,qrel,hi);}while(0)
  #define KBIAS(P0,P1,t) do{ const lds_cptr kb_=shm3+LDS_KB+(t)*256+hi*16; _Pragma("unroll") for(int g_=0;g_<4;++g_){ \
      const f32x4_t a_=*(const __attribute__((address_space(3))) f32x4_t*)(kb_+g_*32), b_=*(const __attribute__((address_space(3))) f32x4_t*)(kb_+g_*32+128); \
      P0[4*g_]=a_[0]-mhat;P0[4*g_+1]=a_[1]-mhat;P0[4*g_+2]=a_[2]-mhat;P0[4*g_+3]=a_[3]-mhat; P1[4*g_]=b_[0]-mhat;P1[4*g_+1]=b_[1]-mhat;P1[4*g_+2]=b_[2]-mhat;P1[4*g_+3]=b_[3]-mhat; \
      if(g_&1){asm volatile("":::"memory");} } }while(0)
  bool resc=false;
  #define START(P0,P1) do{ const float rm=rowmax(P0,P1); resc=false; \
    { const float dl=rm; mhat=fadd_s(mhat,dl); \
      _Pragma("unroll") for(int r=0;r<16;++r){P0[r]=fsub_s(P0[r],dl);P1[r]=fsub_s(P1[r],dl);} \
      } \
    _Pragma("unroll") for(int r=0;r<16;++r)P0[r]=__builtin_amdgcn_exp2f(P0[r]); }while(0)
  #define RESC() do{ if(resc){ asm volatile("s_waitcnt lgkmcnt(0)":::"memory"); \
      _Pragma("unroll") for(int d_=0;d_<2;++d_) _Pragma("unroll") for(int r=0;r<16;++r)o[d_][r]*=wsf[crow(r,hi)]; } }while(0)
  f32x16 pA0,pA1,pB0,pB1;
  int sl_prev=0,sl_cur=0,sl_next=SLOTB;
  #define ROT() do{sl_prev=sl_cur;sl_cur=sl_next;sl_next=(sl_next==(NSLOT-1)*SLOTB)?0:sl_next+SLOTB;}while(0)
  DMA_K(2,2*SLOTB);
  WAIT_BAR(3);
  KBIAS(pA0,pA1,0); qkt(pA0,pA1,Kbase,qr,r32,hi);asm volatile("s_nop 15\n\ts_nop 7":"+v"(pA0),"+v"(pA1));CMASK(pA0,pA1,0);
  START(pA0,pA1);
  _Pragma("unroll") for(int r=0;r<16;++r)pA1[r]=__builtin_amdgcn_exp2f(pA1[r]);
  WAIT_BAR(0);
  DMA_K(3,0);DMA_V(1,SLOTB);
  ROT();
  kload8(kf,kp0+sl_cur);
  WAIT_BAR(2);
  s16x4 vlo[8],vhi[8]; u32x4 pw0,pw1,pw2,pw3;
  #define PKW(P,B) cvtpk_s(P[B],P[B+1])
  #define PAF(k) __builtin_bit_cast(bf16x8,pw##k)
  #define VFR(i) (bf16x8){vlo[i][0],vlo[i][1],vlo[i][2],vlo[i][3],vhi[i][0],vhi[i][1],vhi[i][2],vhi[i][3]}
  #define PIN(x) asm volatile("":"+v"(x))
  #define MX3(a,b,c) __builtin_fmaxf(__builtin_fmaxf((a),(b)),(c))
  #define GAPA(MF,A0,A1,A2,A3,W0,W1,PW) do{ MF; sacc+=A0; sacc+=A1; sacc+=A2; sacc+=A3; PIN(sacc); W0; W1; PIN(PW); SBAR(); }while(0)
  #define EX(v) __builtin_amdgcn_exp2f(v)
  #define GAPB(MF,X,B) do{ MF; X[B]=EX(X[B]); X[B+1]=EX(X[B+1]); X[B+2]=EX(X[B+2]); X[B+3]=EX(X[B+3]); PIN(X); SBAR(); }while(0)
  #define VRD(i) do{ vlo[i]=vtr(vp_+(((i)>>2)*4096+((i)&3)*1024)); vhi[i]=vtr(vp_+(((i)>>2)*4096+((i)&3)*1024+512)); }while(0)
  #define KRD(G,j) do{ if(G){ kload2(kf,kp0+sl_next,j); SBAR(); } }while(0)
  #define STEP(C0,C1,P0,P1,t,GK,GV,GL) do{ SBAR(); KBIAS(C0,C1,t); \
    const lds_cptr vp_=vp0+sl_prev; \
    VRD(0); SBAR(); float sacc=(P0[0]+P0[1]); \
    GAPA(C0=__builtin_amdgcn_mfma_f32_32x32x16_bf16(kf[0],qr[0],C0,0,0,0), P0[2],P0[3],P0[4],P0[5],     pw0[0]=PKW(P0,0), pw0[1]=PKW(P0,2), pw0); \
    VRD(4); SBAR(); GAPA(C1=__builtin_amdgcn_mfma_f32_32x32x16_bf16(kf[1],qr[0],C1,0,0,0), P0[6],P0[7],P0[8],P0[9],     pw0[2]=PKW(P0,4), pw0[3]=PKW(P0,6), pw0); \
    VRD(1); SBAR(); GAPA(C0=__builtin_amdgcn_mfma_f32_32x32x16_bf16(kf[2],qr[1],C0,0,0,0),   P0[10],P0[11],P0[12],P0[13], pw1[0]=PKW(P0,8), pw1[1]=PKW(P0,10), pw1); \
    VRD(5); SBAR(); GAPA(C1=__builtin_amdgcn_mfma_f32_32x32x16_bf16(kf[3],qr[1],C1,0,0,0),   P0[14],P0[15],P1[0],P1[1],   pw1[2]=PKW(P0,12),pw1[3]=PKW(P0,14), pw1); \
    VRD(2); SBAR(); GAPA(C0=__builtin_amdgcn_mfma_f32_32x32x16_bf16(kf[4],qr[2],C0,0,0,0),   P1[2],P1[3],P1[4],P1[5],     pw2[0]=PKW(P1,0), pw2[1]=PKW(P1,2), pw2); \
    VRD(6); SBAR(); GAPA(C1=__builtin_amdgcn_mfma_f32_32x32x16_bf16(kf[5],qr[2],C1,0,0,0),   P1[6],P1[7],P1[8],P1[9],     pw2[2]=PKW(P1,4), pw2[3]=PKW(P1,6), pw2); \
    VRD(3); SBAR(); GAPA(C0=__builtin_amdgcn_mfma_f32_32x32x16_bf16(kf[6],qr[3],C0,0,0,0),   P1[10],P1[11],P1[12],P1[13], pw3[0]=PKW(P1,8), pw3[1]=PKW(P1,10), pw3); \
    VRD(7); SBAR(); GAPA(C1=__builtin_amdgcn_mfma_f32_32x32x16_bf16(kf[7],qr[3],C1,0,0,0),   P1[14],P1[15],0.f,0.f,       pw3[2]=PKW(P1,12),pw3[3]=PKW(P1,14), pw3); \
    l_reg+=sacc; \
    if(GK){DMA_K((t)+3,sl_cur);} if(GV){DMA_V((t)+1,sl_next);} \
    CMASK(C0,C1,t); \
    { float a=MX3(C0[0],C0[1],C1[0]),b=MX3(C0[2],C0[3],C1[1]); a=MX3(a,C1[2],C1[3]); \
      _Pragma("unroll") for(int r=4;r<16;r+=4){a=MX3(a,C0[r],C0[r+1]);b=MX3(b,C0[r+2],C0[r+3]);a=MX3(a,C1[r],C1[r+1]);b=MX3(b,C1[r+2],C1[r+3]);} \
      float rm=__builtin_fmaxf(a,b); { auto rr=__builtin_amdgcn_permlane32_swap(__float_as_uint(rm),__float_as_uint(rm),false,false); rm=__builtin_fmaxf(__uint_as_float(rr[0]),__uint_as_float(rr[1])); } \
      resc=false; \
      if(__builtin_expect(__any(rm>(float)THRL),0)){ const float dl=__builtin_fmaxf(rm,0.f); mhat+=dl; \
        _Pragma("unroll") for(int r=0;r<16;++r){C0[r]-=dl;C1[r]-=dl;} \
        const float f=__builtin_amdgcn_exp2f(-dl); l_reg*=f; if(hi==0)wsf[r32]=f; resc=true; } } \
    SBAR(); \
    GAPB(o[0]=__builtin_amdgcn_mfma_f32_32x32x16_bf16(PAF(0),VFR(0),o[0],0,0,0), C0,0); \
    GAPB(o[1]=__builtin_amdgcn_mfma_f32_32x32x16_bf16(PAF(0),VFR(4),o[1],0,0,0), C0,4); \
    KRD(GL,0); GAPB(o[0]=__builtin_amdgcn_mfma_f32_32x32x16_bf16(PAF(1),VFR(1),o[0],0,0,0), C0,8); \
    KRD(GL,1); GAPB(o[1]=__builtin_amdgcn_mfma_f32_32x32x16_bf16(PAF(1),VFR(5),o[1],0,0,0), C0,12); \
    KRD(GL,2); GAPB(o[0]=__builtin_amdgcn_mfma_f32_32x32x16_bf16(PAF(2),VFR(2),o[0],0,0,0), C1,0); \
    KRD(GL,3); GAPB(o[1]=__builtin_amdgcn_mfma_f32_32x32x16_bf16(PAF(2),VFR(6),o[1],0,0,0), C1,4); \
    GAPB(o[0]=__builtin_amdgcn_mfma_f32_32x32x16_bf16(PAF(3),VFR(3),o[0],0,0,0), C1,8); \
    GAPB(o[1]=__builtin_amdgcn_mfma_f32_32x32x16_bf16(PAF(3),VFR(7),o[1],0,0,0), C1,12); \
    }while(0)
  int t=1;
  #undef CMASK
  #define CMASK(P0,P1,t) do{}while(0)
  for(;t+5<NT;t+=2){
    STEP(pB0,pB1,pA0,pA1,t,true,true,true);     WAIT_BAR(2); RESC(); ROT();
    STEP(pA0,pA1,pB0,pB1,t+1,true,true,true);   WAIT_BAR(2); RESC(); ROT();
  }
  #undef CMASK
  #define CMASK(P0,P1,t) do{int jb_=(t)-(NT-4); if(jb_>=0)cmask(P0,P1,jb_,qrel,hi);}while(0)
  #define ENDW(tt) do{ if((tt)+3<NT){WAIT_BAR(2);} else if((tt)+2<NT){WAIT_BAR(1);} else {WAIT_BAR(0);} }while(0)
  for(;t+1<NT;t+=2){
    STEP(pB0,pB1,pA0,pA1,t,(t+3<NT),(t+1<NT),(t+1<NT));       ENDW(t);   RESC(); ROT();
    STEP(pA0,pA1,pB0,pB1,t+1,(t+4<NT),(t+2<NT),(t+2<NT));     ENDW(t+1); RESC(); ROT();
  }
  STEP(pB0,pB1,pA0,pA1,NT-1,false,false,false); RESC();
  { float sacc=pB0[0]+pB0[1]; _Pragma("unroll") for(int r=2;r<16;++r)sacc+=pB0[r]; _Pragma("unroll") for(int r=0;r<16;++r)sacc+=pB1[r]; l_reg+=sacc;
    pw0=(u32x4){PKW(pB0,0),PKW(pB0,2),PKW(pB0,4),PKW(pB0,6)};pw1=(u32x4){PKW(pB0,8),PKW(pB0,10),PKW(pB0,12),PKW(pB0,14)};pw2=(u32x4){PKW(pB1,0),PKW(pB1,2),PKW(pB1,4),PKW(pB1,6)};pw3=(u32x4){PKW(pB1,8),PKW(pB1,10),PKW(pB1,12),PKW(pB1,14)};
    SBAR(); pv(o,vb0+sl_cur,PAF(0),PAF(1),PAF(2),PAF(3)); }
  #undef PKW
  #undef PAF
  #undef VFR
  #undef PIN
  #undef MX3
  #undef GAPA
  #undef GAPB
  #undef EX
  #undef VRD
  #undef KRD
  #undef STEP
  #undef ENDW
  {auto rr=__builtin_amdgcn_permlane32_swap(__float_as_uint(l_reg),__float_as_uint(l_reg),false,false);l_reg=__uint_as_float(rr[0])+__uint_as_float(rr[1]);}
  if(hi==0)wsf[32+r32]=l_reg;asm volatile("s_waitcnt lgkmcnt(0)":::"memory");
  float rli[16];
  #pragma unroll
  for(int r=0;r<16;++r)rli[r]=__builtin_amdgcn_rcpf(wsf[32+crow(r,hi)]);
  bf16*Ow=O+(rowbase+q0+wid*QBLK)*OPITCH+h*D;
  { bf16*stg=(bf16*)(shm+LDS_OST)+wid*2048;
    #pragma unroll
    for(int r=0;r<16;++r){const int orow=crow(r,hi);
      #pragma unroll
      for(int d0=0;d0<2;++d0)stg[orow*64+d0*32+r32]=__float2bfloat16(o[d0][r]*rli[r]);}
    asm volatile("s_waitcnt lgkmcnt(0)":::"memory");
    #pragma unroll
    for(int i=0;i<4;++i){const int row=i*8+(lane>>3),ch=lane&7; const u32x4 v=*(const u32x4*)(stg+row*64+ch*8);
      float x[8]; _Pragma("unroll") for(int j=0;j<4;++j){x[2*j]=__uint_as_float(v[j]<<16);x[2*j+1]=__uint_as_float(v[j]&0xffff0000u);}
      float ss=0.f; _Pragma("unroll") for(int j=0;j<8;++j)ss+=x[j]*x[j];
      ss+=__shfl_xor(ss,1);ss+=__shfl_xor(ss,2);ss+=__shfl_xor(ss,4);
      const float rs=__builtin_amdgcn_rsqf(ss*(1.0f/64.0f)+1e-5f); const f32x4_t w0=*(const f32x4_t*)(onw+h*D+ch*8),w1=*(const f32x4_t*)(onw+h*D+ch*8+4);
      u32x4 ov; ov[0]=cvtpk_s(x[0]*rs*w0[0],x[1]*rs*w0[1]);ov[1]=cvtpk_s(x[2]*rs*w0[2],x[3]*rs*w0[3]);ov[2]=cvtpk_s(x[4]*rs*w1[0],x[5]*rs*w1[1]);ov[3]=cvtpk_s(x[6]*rs*w1[2],x[7]*rs*w1[3]);
      ATTN_STORE16(Ow+(long)row*OPITCH+ch*8,ov);} }
  asm volatile("s_waitcnt lgkmcnt(0)\n\ts_barrier":::"memory");
  #undef DMA_K
  #undef DMA_V
  #undef CMASK
  #undef KBIAS
  #undef START
  #undef RESC
  #undef ROT
}
constexpr int ATTN_LDS_BYTES=LDS_BYTES;
struct AttnTensors { const bf16* Q; const bf16* K; const bf16* V; bf16* O; const float* kbias; const float* onw; };
struct AttnUnit { int bh; int qb; };
struct StaticOrder {
  int vcu,G;
  __device__ __forceinline__ StaticOrder(int grid,int vcu_):vcu(vcu_),G(grid){}
  __device__ __forceinline__ bool next(int i,AttnUnit&u)const{ const int pi=vcu+G*(i>>1); if(pi>=BATCH*NHEAD*(NQB/2))return false; const int s=pi&3; u.bh=pi>>2; u.qb=(i&1)?(NQB-1-s):s; return true; }
};
template<class Sched,int THRL=64> __device__ __forceinline__ void attn_phase(char*lds,const AttnTensors&T,const Sched&S,unsigned*done=nullptr,const unsigned*rdy2=nullptr,const unsigned*rdy1=nullptr){
  AttnUnit u;
  for(int i=0;S.next(i,u);++i){
    if(rdy2){ if(threadIdx.x==0){ unsigned sp_=0; while(__hip_atomic_load(rdy2+16*u.bh,__ATOMIC_RELAXED,__HIP_MEMORY_SCOPE_AGENT)<32u&&++sp_<(1u<<22))__builtin_amdgcn_s_sleep(2);
        for(int j=0;j<=u.qb;++j){ sp_=0; while(__hip_atomic_load(rdy1+32*((u.bh/NHEAD)*NQB+j),__ATOMIC_RELAXED,__HIP_MEMORY_SCOPE_AGENT)<96u&&++sp_<(1u<<22))__builtin_amdgcn_s_sleep(2); } }
      __syncthreads(); }
    attn_unit<THRL>(u.bh/NHEAD,u.bh%NHEAD,u.qb,T.Q,T.K,T.V,T.O,T.kbias,T.onw,lds);
    if(done){ asm volatile("s_waitcnt vmcnt(0)":::"memory"); if((threadIdx.x&63)==0)__hip_atomic_fetch_add(done+64*((u.bh/NHEAD)*NQB+u.qb),1u,__ATOMIC_RELAXED,__HIP_MEMORY_SCOPE_AGENT); } }
}
#undef SBAR
#undef WAIT_BAR
}

constexpr int NWAVES = 8;
#ifndef MK_N_LAUNCHES
#define MK_N_LAUNCHES 1
#endif
constexpr int N_PHASES = 10;
constexpr int N_LAUNCHES = MK_N_LAUNCHES;

constexpr size_t MiB = 1u << 20;
constexpr size_t WS_CTL = 0, CTL_ZERO_BYTES = 160 * 1024;
constexpr size_t WS_WIN = 2 * MiB;
constexpr size_t WS_WOUT = 8 * MiB;
constexpr size_t WS_WGU = 10 * MiB;
constexpr size_t WS_WD = 138 * MiB;
constexpr size_t WS_XN = 202 * MiB;
constexpr size_t WS_T6 = 234 * MiB, T6_STRIDE = 16 * MiB;
constexpr size_t WS_MIX = 330 * MiB;
constexpr size_t WS_GATES = 362 * MiB;
constexpr size_t WS_KBIAS = 364 * MiB;
constexpr size_t WS_RW = 364 * MiB + 512 * 1024;
constexpr size_t WS_MST = 365 * MiB;
constexpr size_t WS_ROUTE = 383 * MiB;
constexpr size_t WS_X1B = 480 * MiB;
constexpr size_t WS_MPS = 460 * MiB;
constexpr size_t WS_ACT = 386 * MiB;
constexpr size_t WS_Y = 530 * MiB;
constexpr size_t WS_END = 674 * MiB;
constexpr int MST_PITCH = 2048 + 64;
constexpr size_t RT_TOPI = 0, RT_TOPW = 256 * 1024, RT_HIST = 512 * 1024, RT_POSSLOT = 1024 * 1024, RT_TOKPOS = 1280 * 1024, RT_GATEPOS = 1600 * 1024, RT_TILEPREF = 2048 * 1024;
constexpr int NSEG = MTOK / 64;
static_assert(WS_ACT + (size_t)MAXPOS * DE * 2 <= WS_Y && WS_Y + (size_t)MAXPOS * DMODEL * 2 <= WS_END && WS_MST + (size_t)2048 * MST_PITCH * 4 <= WS_ROUTE, "d_ws map");
constexpr int CW_BAR = 4096;
constexpr int CW_MOE = 16384;

constexpr int RING_BYTES = 143360;
constexpr int LDSCTL_OFF = RING_BYTES, MISC_OFF = LDSCTL_OFF + 320;
constexpr int LDS_BYTES = 147456;

#define GAS __attribute__((address_space(1)))
#define LAS __attribute__((address_space(3)))
typedef unsigned short bf16;
typedef unsigned v4u __attribute__((ext_vector_type(4)));
typedef float f32x4 __attribute__((ext_vector_type(4)));
typedef short bf16x8 __attribute__((ext_vector_type(8)));
typedef GAS unsigned gu32;
typedef GAS unsigned long long gu64;
#define RLX_AGENT __ATOMIC_RELAXED, __HIP_MEMORY_SCOPE_AGENT
#define LDS_WAIT() asm volatile("s_waitcnt lgkmcnt(0)" ::: "memory")
#define VM_WAIT() asm volatile("s_waitcnt vmcnt(0)" ::: "memory")
__device__ __forceinline__ unsigned long long rt() { return __builtin_amdgcn_s_memrealtime(); }
__device__ __forceinline__ unsigned f2bf(float f) { return (unsigned)__builtin_bit_cast(unsigned short, (__bf16)f); }
typedef float f32x2_pk __attribute__((ext_vector_type(2))); typedef __bf16 bf16x2_pk __attribute__((ext_vector_type(2)));
__device__ __forceinline__ unsigned pk2(float lo, float hi) { const f32x2_pk v = {lo, hi}; return __builtin_bit_cast(unsigned, __builtin_convertvector(v, bf16x2_pk)); }

#define XB_TMO      128
#define XB_XCNT(j)  (256  + 64 * (j))
#define XB_XSUB(j)  (1280 + 64 * (j))
#define XB_XGEN(j)  (2304 + 64 * (j))
#define XB_TOP      3328
#define XB_TOPGEN   3392
#define XCD_BAR_WORDS 3456
#define XB_SPIN_CAP (1u << 18)

__device__ __forceinline__ unsigned xb_ld(unsigned* p)              { return __hip_atomic_load(p, __ATOMIC_RELAXED, __HIP_MEMORY_SCOPE_AGENT); }
__device__ __forceinline__ unsigned xb_add(unsigned* p, unsigned v) { return __hip_atomic_fetch_add(p, v, __ATOMIC_RELAXED, __HIP_MEMORY_SCOPE_AGENT); }
__device__ __forceinline__ unsigned xb_xcc_id() { return (unsigned)__builtin_amdgcn_s_getreg((3 << 11) | 20) & 0xFu; }
#define XB_SPIN(cond, bar) do { unsigned _sp = 0; while (cond) { __builtin_amdgcn_s_sleep(1); \
    if ((++_sp & 255u) == 0u) { if (xb_ld(&(bar)[XB_TMO])) break; if (_sp > XB_SPIN_CAP) { atomicAdd(&(bar)[XB_TMO], 1u); break; } } } } while (0)

struct XcdBarrier {
    unsigned* bar; unsigned x;
    volatile LAS unsigned* st;
};

__device__ __forceinline__ XcdBarrier xcd_barrier_post(unsigned* bar, volatile LAS unsigned* st) {
    XcdBarrier b; b.bar = bar; b.x = xb_xcc_id(); b.st = st;
    if (threadIdx.x == 0) { const unsigned rank_ = xb_add(&bar[XB_XCNT(b.x)], 1u); st[2] = rank_; st[3] = b.x; }
    return b;
}
__device__ __forceinline__ void xcd_barrier_complete(unsigned* bar, unsigned x, unsigned& nloc, unsigned& nx) {
    const unsigned G = gridDim.x * gridDim.y * gridDim.z;
    unsigned sum, cnt, mine, sp = 0u;
    for (;;) {
        sum = 0u; cnt = 0u; mine = 0u;
#pragma unroll
        for (unsigned j = 0; j < 16; ++j) { const unsigned c = xb_ld(&bar[XB_XCNT(j)]); sum += c; cnt += (c > 0u) ? 1u : 0u; mine = (j == x) ? c : mine; }
        if (sum == G) break;
        __builtin_amdgcn_s_sleep(1);
        if ((++sp & 255u) == 0u) { if (xb_ld(&bar[XB_TMO])) break; if (sp > XB_SPIN_CAP) { atomicAdd(&bar[XB_TMO], 1u); break; } }
    }
    nloc = mine > 0u ? mine : 1u; nx = cnt > 0u ? cnt : 1u;
}

__device__ __forceinline__ void xcd_barrier(const XcdBarrier& b) {
    asm volatile("s_waitcnt vmcnt(0)" ::: "memory");
    __syncthreads();
    if (threadIdx.x == 0) {
        unsigned* bar = b.bar;
        __builtin_amdgcn_s_waitcnt(0);
        unsigned nloc = b.st[0], nx = b.st[1];
        if (nloc == 0u) { xcd_barrier_complete(bar, b.x, nloc, nx); b.st[0] = nloc; b.st[1] = nx; }
        const unsigned old = xb_add(&bar[XB_XSUB(b.x)], 1u);
        const unsigned gen = old / nloc;
        if (old + 1u == (gen + 1u) * nloc) {
            __builtin_amdgcn_fence(__ATOMIC_RELEASE, "agent");
            asm volatile("s_waitcnt vmcnt(0)" ::: "memory");
            const unsigned og = xb_add(&bar[XB_TOP], 1u);
            const unsigned tg = og / nx;
            if (og + 1u == (tg + 1u) * nx) xb_add(&bar[XB_TOPGEN], 1u);
            else XB_SPIN(xb_ld(&bar[XB_TOPGEN]) == tg, bar);
            __builtin_amdgcn_fence(__ATOMIC_ACQUIRE, "agent");
            xb_add(&bar[XB_XGEN(b.x)], 1u);
            asm volatile("s_waitcnt vmcnt(0)" ::: "memory");
        } else {
            XB_SPIN(xb_ld(&bar[XB_XGEN(b.x)]) == gen, bar);
            __builtin_amdgcn_fence(__ATOMIC_ACQUIRE, "agent");
            asm volatile("s_waitcnt vmcnt(0)" ::: "memory");
        }
    }
    __syncthreads();
}

__device__ __forceinline__ void xcd_event_post(const XcdBarrier& b, unsigned* ev) {
    asm volatile("s_waitcnt vmcnt(0)" ::: "memory");
    __syncthreads();
    if (threadIdx.x == 0) {
        __builtin_amdgcn_s_waitcnt(0);
        unsigned nloc = b.st[0], nx = b.st[1];
        if (nloc == 0u) { xcd_barrier_complete(b.bar, b.x, nloc, nx); b.st[0] = nloc; b.st[1] = nx; }
        const unsigned old = xb_add(&ev[64 * b.x], 1u);
        if (old + 1u == nloc) { __builtin_amdgcn_fence(__ATOMIC_RELEASE, "agent"); asm volatile("s_waitcnt vmcnt(0)" ::: "memory"); xb_add(&ev[64 * 16], 1u); }
    }
}
__device__ __forceinline__ void xcd_event_wait(const XcdBarrier& b, unsigned* ev) {
    if (threadIdx.x == 0) {
        const unsigned nx = b.st[1];
        XB_SPIN(xb_ld(&ev[64 * 16]) < nx, b.bar);
        __builtin_amdgcn_fence(__ATOMIC_ACQUIRE, "agent");
        asm volatile("s_waitcnt vmcnt(0)" ::: "memory");
    }
    __syncthreads();
}

__device__ __forceinline__ float bf2f(unsigned short x) { return __uint_as_float((unsigned)x << 16); }
__device__ __forceinline__ float bflo(unsigned w) { return __uint_as_float(w << 16); }
__device__ __forceinline__ float bfhi(unsigned w) { return __uint_as_float(w & 0xffff0000u); }
__device__ __forceinline__ float wave_sum(float v) {
#pragma unroll
    for (int o = 1; o < 64; o <<= 1) v += __shfl_xor(v, o);
    return v;
}
__device__ __forceinline__ float wave_max(float v) {
#pragma unroll
    for (int o = 1; o < 64; o <<= 1) v = fmaxf(v, __shfl_xor(v, o));
    return v;
}
__device__ __forceinline__ float wave_scan_sum(float v, int lane) {
#pragma unroll
    for (int o = 1; o < 64; o <<= 1) { const float t = __shfl_up(v, o); if (lane >= o) v += t; }
    return v;
}
__device__ __forceinline__ float wave_scan_max(float v, int lane) {
#pragma unroll
    for (int o = 1; o < 64; o <<= 1) { const float t = __shfl_up(v, o); if (lane >= o) v = fmaxf(v, t); }
    return v;
}
__device__ __forceinline__ float readlane_f(float v, int l) { return __uint_as_float(__builtin_amdgcn_readlane(__float_as_uint(v), l)); }
__device__ __forceinline__ float reduce32(const float (&v)[32], int lane) {
    float a[16], b[8], c[4], d[2];
#pragma unroll
    for (int e = 0; e < 16; ++e) { const auto r = __builtin_amdgcn_permlane32_swap(__float_as_uint(v[e]), __float_as_uint(v[16 + e]), false, false); a[e] = __uint_as_float(r[0]) + __uint_as_float(r[1]); }
#pragma unroll
    for (int e = 0; e < 8; ++e) { const auto r = __builtin_amdgcn_permlane16_swap(__float_as_uint(a[e]), __float_as_uint(a[8 + e]), false, false); b[e] = __uint_as_float(r[0]) + __uint_as_float(r[1]); }
#pragma unroll
    for (int e = 0; e < 4; ++e) { const float send = (lane & 8) ? b[e] : b[4 + e], keep = (lane & 8) ? b[4 + e] : b[e]; c[e] = keep + __shfl_xor(send, 8); }
#pragma unroll
    for (int e = 0; e < 2; ++e) { const float send = (lane & 4) ? c[e] : c[2 + e], keep = (lane & 4) ? c[2 + e] : c[e]; d[e] = keep + __shfl_xor(send, 4); }
    const float send = (lane & 2) ? d[0] : d[1], keep = (lane & 2) ? d[1] : d[0];
    float r = keep + __shfl_xor(send, 2);
    r += __shfl_xor(r, 1);
    return r;
}
__device__ __forceinline__ void fmac_s(float& c, float a, float b) { asm("v_fmac_f32_e32 %0, %1, %2" : "+v"(c) : "v"(a), "v"(b)); }
__device__ __forceinline__ float log_sigmoid(float z) { return fminf(z, 0.f) - log1pf(expf(-fabsf(z))); }

template <bool F8> __device__ __forceinline__ void p0_item(const float* src, int ldw, unsigned char* dst, LAS float* scr, int lane) {
    constexpr int KR = F8 ? 128 : 64;
    {
        const float* sp = src + (size_t)(lane >> 5) * ldw + (lane & 31); LAS float* dp = scr + (lane >> 5) * 33 + (lane & 31);
        float l0[16], l1[16], l2[16], l3[16];
#pragma unroll
        for (int i = 0; i < 16; ++i) l0[i] = __builtin_nontemporal_load(sp + (size_t)(2 * i) * ldw);
#pragma unroll
        for (int i = 0; i < 16; ++i) l1[i] = __builtin_nontemporal_load(sp + (size_t)(2 * i + 32) * ldw);
        if constexpr (F8) {
#pragma unroll
            for (int i = 0; i < 16; ++i) l2[i] = __builtin_nontemporal_load(sp + (size_t)(2 * i + 64) * ldw);
#pragma unroll
            for (int i = 0; i < 16; ++i) l3[i] = __builtin_nontemporal_load(sp + (size_t)(2 * i + 96) * ldw);
        }
#pragma unroll
        for (int i = 0; i < 16; ++i) dp[(2 * i) * 33] = l0[i];
#pragma unroll
        for (int i = 0; i < 16; ++i) dp[(2 * i + 32) * 33] = l1[i];
        if constexpr (F8) {
#pragma unroll
            for (int i = 0; i < 16; ++i) dp[(2 * i + 64) * 33] = l2[i];
#pragma unroll
            for (int i = 0; i < 16; ++i) dp[(2 * i + 96) * 33] = l3[i];
        }
    }
    LDS_WAIT(); asm volatile("" ::: "memory");
    if constexpr (!F8) {
        const int c = lane & 7;
#pragma unroll
        for (int j = 0; j < 4; ++j) { const int n = (lane >> 3) + 8 * j; const LAS float* s = scr + (8 * c) * 33 + n;
            v4u o; o.x = pk2(s[0 * 33], s[1 * 33]); o.y = pk2(s[2 * 33], s[3 * 33]); o.z = pk2(s[4 * 33], s[5 * 33]); o.w = pk2(s[6 * 33], s[7 * 33]);
            *(GAS v4u*)(dst + ((size_t)n * 1024 + 8 * c) * 2) = o; }
    } else {
        const int c = lane >> 3;
#pragma unroll
        for (int j = 0; j < 4; ++j) { const int n = (lane & 7) + 8 * j; const LAS float* s = scr + (16 * c) * 33 + n; v4u o;
#pragma unroll
            for (int q = 0; q < 4; ++q) { int pk = __builtin_amdgcn_cvt_pk_fp8_f32(s[(4 * q) * 33] * 32.0f, s[(4 * q + 1) * 33] * 32.0f, 0, false);
                pk = __builtin_amdgcn_cvt_pk_fp8_f32(s[(4 * q + 2) * 33] * 32.0f, s[(4 * q + 3) * 33] * 32.0f, pk, true); o[q] = (unsigned)pk; }
            __builtin_nontemporal_store(o, (GAS v4u*)(dst + (size_t)n * 1024 + 16 * c)); }
    }
    LDS_WAIT(); asm volatile("" ::: "memory");
}
struct P0Args { const float *x, *attn_norm_w, *w_in, *fox_f_bias, *mlstm_i_bias, *mlstm_f_bias, *w_out, *w_gu, *w_d; bf16 *WIN, *WOUT; unsigned char *WGU, *WD; bf16* XN; float* GATES; float* KB; const float* router_w; bf16* RW; unsigned* tick; };
#ifndef TS_PHASE
#define TS_PHASE -1
#endif
__device__ __forceinline__ unsigned long long p0_prologue(const P0Args& A, LAS unsigned char* lds, int vcu, int G, int tid, int lane, int wave, int part) {
    unsigned long long tsv = 0ull;
    LAS float* scr = (LAS float*)(lds + wave * 16896);
    LAS float* gwT = (LAS float*)lds;
    LAS int* tkl = (LAS int*)(lds + NWAVES * 16896);
    constexpr int NI_IN = 16 * 96, NI_OUT = 16 * 32, NI_GU = NE * 8 * 64, NI_D = NE * 8 * 32, NITEMS = NI_IN + NI_OUT + NI_GU + NI_D;
    constexpr int NWR = NITEMS / NWAVES, NRR = MTOK / (4 * NWAVES);
    static_assert(NITEMS % NWAVES == 0 && MTOK % (4 * NWAVES) == 0, "ticket rounds");
    if (part == 0) for (int idx = vcu * NWAVES * 64 + tid; idx < DMODEL * NE; idx += G * NWAVES * 64) {
        const int k = idx >> 5, e = idx & 31; const float w = A.router_w[idx]; const unsigned h = f2bf(w); const float r = w - bf2f((unsigned short)h);
        A.RW[(size_t)e * DMODEL + k] = (bf16)h; A.RW[32768 + (size_t)e * DMODEL + k] = (bf16)f2bf(r); }
    f32x4 wn[4];
#pragma unroll
    for (int j = 0; j < 4; ++j) wn[j] = *(const f32x4*)(A.attn_norm_w + 4 * lane + 256 * j);
    constexpr int NBF = (NI_IN + NI_OUT) / NWAVES;
    static_assert((NI_IN + NI_OUT) % NWAVES == 0, "bf16 rounds");
    const bool solo = G < 2;
#pragma unroll 1
    for (int st = 0; st < 2; ++st) {
        if (part == 1 && st == 1) break;
        if (part == 0 && !solo && st != ((vcu & 1) == 0 ? 0 : 1)) continue;
        __syncthreads();
        unsigned* wctr = part == 0 ? A.tick + 128 : A.tick; const int wbase = part == 0 ? 0 : NBF, wlim = part == 0 ? NBF : NWR - NBF;
        if (part == 0 && st == 0) {
            if (tid == 0) tkl[0] = (int)__hip_atomic_fetch_add(A.tick + 64, 1u, __ATOMIC_RELAXED, __HIP_MEMORY_SCOPE_AGENT);
            __syncthreads();
            int t = __builtin_amdgcn_readfirstlane(tkl[0]);
            if (t < NRR) {
                {
                    f32x4 gv[12]; int tq = tid; asm volatile("" : "+v"(tq));
#pragma unroll
                    for (int i = 0; i < 12; ++i) { const int idx = tq + i * (NWAVES * 64), hf = idx & 1, k = (idx >> 1) & 1023, g3 = idx >> 11; const int base = g3 == 0 ? 1536 : (g3 == 1 ? 2568 : 2576);
                        gv[i] = *(const f32x4*)(A.w_in + (size_t)k * INW + base + 4 * hf); }
#pragma unroll
                    for (int i = 0; i < 12; ++i) { const int idx = tq + i * (NWAVES * 64), hf = idx & 1, k = (idx >> 1) & 1023, g3 = idx >> 11; LAS float* d = gwT + (8 * g3 + 4 * hf) * 1028 + k;
                        d[0] = gv[i].x; d[1028] = gv[i].y; d[2 * 1028] = gv[i].z; d[3 * 1028] = gv[i].w; }
                }
            }
#pragma unroll 1
            while (t < NRR) {
                __syncthreads();
                int tnext = 0; if (tid == 0) tnext = (int)__hip_atomic_fetch_add(A.tick + 64, 1u, __ATOMIC_RELAXED, __HIP_MEMORY_SCOPE_AGENT);
                const int m0 = (t * NWAVES + wave) * 4;
                f32x4 v[4][4];
#pragma unroll
                for (int u = 0; u < 4; ++u) { const GAS f32x4* xr = (const GAS f32x4*)(A.x + (size_t)(m0 + u) * DMODEL) + lane;
#pragma unroll
                    for (int j = 0; j < 4; ++j) v[u][j] = xr[64 * j]; }
#pragma unroll
                for (int u = 0; u < 4; ++u) { float s = 0.f;
#pragma unroll
                    for (int j = 0; j < 4; ++j) s += (v[u][j].x * v[u][j].x + v[u][j].y * v[u][j].y) + (v[u][j].z * v[u][j].z + v[u][j].w * v[u][j].w);
                    const float rstd = 1.f / sqrtf(wave_sum(s) * (1.f / DMODEL) + NORM_EPS);
                    GAS unsigned long long* o8 = (GAS unsigned long long*)(A.XN + (size_t)(m0 + u) * DMODEL) + lane;
#pragma unroll
                    for (int j = 0; j < 4; ++j) { v[u][j] = v[u][j] * rstd * wn[j]; o8[64 * j] = (unsigned long long)pk2(v[u][j].x, v[u][j].y) | ((unsigned long long)pk2(v[u][j].z, v[u][j].w) << 32); } }
#pragma unroll
                for (int cg = 0; cg < 3; ++cg) {
                    float p[32];
#pragma unroll
                    for (int cc = 0; cc < 8; ++cc) { const int c = cg * 8 + cc; f32x2_pk a[4] = {(f32x2_pk){0.f, 0.f}, (f32x2_pk){0.f, 0.f}, (f32x2_pk){0.f, 0.f}, (f32x2_pk){0.f, 0.f}};
#pragma unroll
                        for (int j = 0; j < 4; ++j) { const f32x4 w4 = *(const LAS f32x4*)(gwT + c * 1028 + 256 * j + 4 * lane); const f32x2_pk wl = __builtin_shufflevector(w4, w4, 0, 1), wh = __builtin_shufflevector(w4, w4, 2, 3);
#pragma unroll
                            for (int u = 0; u < 4; ++u) { a[u] = __builtin_elementwise_fma(__builtin_shufflevector(v[u][j], v[u][j], 0, 1), wl, a[u]); a[u] = __builtin_elementwise_fma(__builtin_shufflevector(v[u][j], v[u][j], 2, 3), wh, a[u]); } }
#pragma unroll
                        for (int u = 0; u < 4; ++u) p[u * 8 + cc] = a[u].x + a[u].y; }
                    const float val = reduce32(p, lane);
                    const int e = lane >> 1, cc = e & 7, m = m0 + (e >> 3);
                    if ((lane & 1) == 0) {
                        float o;
                        if (cg == 0) { o = log_sigmoid(val + A.fox_f_bias[cc]); A.KB[(size_t)((m >> 11) * 8 + cc) * SEQ + (m & (SEQ - 1))] = o; }
                        else if (cg == 1) o = val + A.mlstm_i_bias[cc];
                        else o = log_sigmoid(val + A.mlstm_f_bias[cc]);
                        A.GATES[(size_t)m * 24 + cg * 8 + cc] = o; }
                    asm volatile("" ::: "memory");
                }
                if (tid == 0) tkl[0] = tnext;
                __syncthreads();
                t = __builtin_amdgcn_readfirstlane(tkl[0]);
            }
        } else {
            if (tid == 0) tkl[0] = (int)__hip_atomic_fetch_add(wctr, 1u, __ATOMIC_RELAXED, __HIP_MEMORY_SCOPE_AGENT);
            __syncthreads();
            int t = __builtin_amdgcn_readfirstlane(tkl[0]);
#pragma unroll 1
            while (t < wlim) {
                __syncthreads();
                int tnext = 0; if (tid == 0) tnext = (int)__hip_atomic_fetch_add(wctr, 1u, __ATOMIC_RELAXED, __HIP_MEMORY_SCOPE_AGENT);
                do {
                    int r = (t + wbase) * NWAVES + wave;
                    if (r < NI_IN) { const int kb = r / 96, nb = r % 96, drow = 32 * nb, pn = drow >> 8, p0 = drow & 255, cl = 256 * pn + 64 * ((p0 >> 5) & 3) + 32 * (p0 >> 7);
                        const int src = cl + (cl < 1536 ? 0 : (cl < 2560 ? 8 : 24));
                        p0_item<false>(A.w_in + (size_t)(64 * kb) * INW + src, INW, (unsigned char*)(A.WIN + (size_t)drow * 1024 + 64 * kb), scr, lane); continue; }
                    r -= NI_IN;
                    if (r < NI_OUT) { const int kb = r / 32, nb = r % 32;
                        p0_item<false>(A.w_out + (size_t)(64 * kb) * DMODEL + 32 * nb, DMODEL, (unsigned char*)(A.WOUT + (size_t)(32 * nb) * 1024 + 64 * kb), scr, lane); continue; }
                    r -= NI_OUT;
                    if (r < NI_GU) { const int e = r / 512, q = r % 512, kb = q / 64, nb = q % 64, drow = 32 * nb, pn = drow >> 8, p0 = drow & 255;
                        const int src = p0 < 128 ? 128 * pn + p0 : 1024 + 128 * pn + (p0 - 128);
                        p0_item<true>(A.w_gu + (size_t)e * DMODEL * 2048 + (size_t)(128 * kb) * 2048 + src, 2048, A.WGU + ((size_t)e * 2048 + drow) * 1024 + 128 * kb, scr, lane); continue; }
                    r -= NI_GU;
                    { const int e = r / 256, q = r % 256, kb = q / 32, nb = q % 32;
                        p0_item<true>(A.w_d + (size_t)e * DE * DMODEL + (size_t)(128 * kb) * DMODEL + 32 * nb, DMODEL, A.WD + ((size_t)e * 1024 + 32 * nb) * 1024 + 128 * kb, scr, lane); }
                } while (0);
                if (tid == 0) tkl[0] = tnext;
                __syncthreads();
                t = __builtin_amdgcn_readfirstlane(tkl[0]);
            }
        }
    }
    return tsv;
}

__device__ __forceinline__ void conv_silu32(const bf16* MQK, const float* cw, int cb, long row, int tseq, float (&out)[32]) {
#pragma unroll
    for (int q = 0; q < 4; ++q) {
        float o[8];
#pragma unroll
        for (int i = 0; i < 8; ++i) o[i] = 0.f;
#pragma unroll
        for (int j = 0; j < 4; ++j) {
            v4u w = (v4u){0u, 0u, 0u, 0u};
            if (tseq - 3 + j >= 0) w = *(const GAS v4u*)(MQK + (size_t)(row - 3 + j) * 512 + cb + 8 * q);
            const float* cj = cw + j * 512 + cb + 8 * q;
#pragma unroll
            for (int i = 0; i < 4; ++i) { o[2 * i] += cj[2 * i] * bflo(w[i]); o[2 * i + 1] += cj[2 * i + 1] * bfhi(w[i]); }
        }
#pragma unroll
        for (int i = 0; i < 8; ++i) out[8 * q + i] = o[i] * __builtin_amdgcn_rcpf(1.0f + __expf(-o[i]));
        asm volatile("" ::: "memory"); __builtin_amdgcn_sched_barrier(0);
    }
}
struct MlArgs { const bf16 *MQK, *MV, *MO; const float *GATES, *conv_w, *out_norm_w; float* MST; bf16* MIX; float* KBIAS; float* MPS; float* KBF; };
__device__ __forceinline__ void ml_local_item(const MlArgs& A, int bh, int c, LAS unsigned char* wl, int lane) {
    asm volatile("" : "+v"(lane));
    const int b = bh >> 3, h = bh & 7; const long row = (long)b * SEQ + c * 64 + lane; const int tseq = c * 64 + lane;
    const float fc = A.GATES[(size_t)row * 24 + 16 + h], ic = A.GATES[(size_t)row * 24 + 8 + h];
    {
        const float* kb = A.KBIAS + (size_t)bh * SEQ; float pacc = 0.f;
        float pv[32];
#pragma unroll
        for (int cc = 0; cc < 32; ++cc) pv[cc] = kb[min(cc, c) * 64 + lane];
#pragma unroll
        for (int cc = 0; cc < 32; ++cc) pacc += (cc < c) ? pv[cc] : 0.f;
        const float own = wave_scan_sum(pv[31], lane);
        A.KBF[(size_t)bh * SEQ + c * 64 + lane] = -(wave_sum(pacc) + own) * LOG2E;
    }
    const float bcum = wave_scan_sum(fc, lane), blast = readlane_f(bcum, 63);
    const float gg = blast - bcum + ic, a = wave_max(gg), wk = __expf(gg - a);
    float kc[32];
    conv_silu32(A.MQK, A.conv_w, 256 + h * 32, row, tseq, kc);
    LAS float* kw = (LAS float*)wl;
    const float sc = wk * 0.17677669529663687f;
#pragma unroll
    for (int q = 0; q < 8; ++q) *(LAS f32x4*)(kw + lane * 36 + 4 * q) = (f32x4){kc[4 * q] * sc, kc[4 * q + 1] * sc, kc[4 * q + 2] * sc, kc[4 * q + 3] * sc};
    LDS_WAIT(); asm volatile("" ::: "memory");
    float acc[32];
#pragma unroll
    for (int d = 0; d < 32; ++d) acc[d] = 0.f;
    LAS unsigned char* vS = wl + 9216;
    { const GAS v4u* vp = (const GAS v4u*)(A.MV + (size_t)row * 512 + h * 64);
#pragma unroll
      for (int j = 0; j < 8; ++j) { const v4u w = vp[j]; *(LAS unsigned long long*)(vS + lane * 136 + 16 * j) = (unsigned long long)w.x | ((unsigned long long)w.y << 32);
          *(LAS unsigned long long*)(vS + lane * 136 + 16 * j + 8) = (unsigned long long)w.z | ((unsigned long long)w.w << 32); } }
    LDS_WAIT(); asm volatile("" ::: "memory");
#pragma unroll 4
    for (int t = 0; t < 64; ++t) {
        const float vt = bf2f(*(const LAS unsigned short*)(vS + t * 136 + lane * 2));
#pragma unroll
        for (int q = 0; q < 8; ++q) { const f32x4 k4 = *(const LAS f32x4*)(kw + t * 36 + 4 * q); acc[4 * q] += k4.x * vt; acc[4 * q + 1] += k4.y * vt; acc[4 * q + 2] += k4.z * vt; acc[4 * q + 3] += k4.w * vt; }
    }
    float* st = A.MST + (size_t)(bh * 32 + c) * MST_PITCH;
#pragma unroll
    for (int d = 0; d < 32; ++d) st[d * 64 + lane] = acc[d];
    if (lane < 32) { float n = 0.f; for (int t = 0; t < 64; ++t) n += kw[t * 36 + lane]; st[2048 + lane] = n; }
    if (lane == 0) { st[2048 + 32] = a; st[2048 + 33] = blast; }
    LDS_WAIT(); asm volatile("" ::: "memory");
}
__device__ __forceinline__ void ml_scan_item(const MlArgs& A, int bh, int slice, int lane) {
    const float* stb = A.MST + (size_t)(bh * 32) * MST_PITCH; float* psb = A.MPS + (size_t)(bh * 32) * MST_PITCH;
    float aB = 0.f, aA = 0.f;
    if (lane < 32) { aB = stb[(size_t)lane * MST_PITCH + 2048 + 33]; aA = stb[(size_t)lane * MST_PITCH + 2048 + 32]; }
    float dec = 0.f, wk = 0.f, mst = 0.f, m = 0.f;
#pragma unroll 1
    for (int c = 0; c < 32; ++c) {
        const float Bc = readlane_f(aB, c), ac = readlane_f(aA, c), mn = fmaxf(Bc + m, ac);
        if (lane == c) { dec = __expf(Bc + m - mn); wk = __expf(ac - mn); mst = m; }
        m = mn;
    }
    const int el = slice * 64 + lane;
    float ld[32];
#pragma unroll
    for (int c = 0; c < 32; ++c) ld[c] = stb[(size_t)c * MST_PITCH + el];
    const float nl = (lane < 32) ? stb[(size_t)lane * MST_PITCH + 2048 + slice] : 0.f;
    float x = 0.f, xn = 0.f, nout = 0.f;
#pragma unroll
    for (int c = 0; c < 32; ++c) {
        psb[(size_t)c * MST_PITCH + el] = x;
        if (lane == c) nout = xn;
        const float dc = readlane_f(dec, c), wc = readlane_f(wk, c);
        x = dc * x + wc * ld[c]; xn = dc * xn + wc * readlane_f(nl, c);
    }
    if (lane < 32) { psb[(size_t)lane * MST_PITCH + 2048 + slice] = nout; if (slice == 0) psb[(size_t)lane * MST_PITCH + 2048 + 32] = mst; }
}
constexpr int ML_WL = 17536;
__device__ __forceinline__ void ml_output_item(const MlArgs& A, int bh, int c, LAS unsigned char* wl, int lane) {
    asm volatile("" : "+v"(lane));
    const int b = bh >> 3, h = bh & 7; const long row0 = (long)b * SEQ + c * 64, row = row0 + lane; const int tseq = c * 64 + lane;
    LAS unsigned char* kL = wl; LAS unsigned char* vL = wl + 4096; LAS unsigned char* cL = wl + 9216; LAS unsigned char* hL = wl + 13312;
    LAS float* nsL = (LAS float*)(wl + 17408);
    const float fc = A.GATES[(size_t)row * 24 + 16 + h], ic = A.GATES[(size_t)row * 24 + 8 + h];
    const float bcum = wave_scan_sum(fc, lane);
    const float beta = ic - bcum, pmax = wave_scan_max(beta, lane);
    const float* ps = A.MPS + (size_t)(bh * 32 + c) * MST_PITCH;
    const float mprev = ps[2048 + 32];
    const float inter = bcum + mprev, m_t = fmaxf(inter, bcum + pmax), w_inter = __expf(inter - m_t), alpha = bcum - m_t;
    {
        float Cs[32];
#pragma unroll
        for (int d = 0; d < 32; ++d) Cs[d] = ps[d * 64 + lane];
        const float ns = ps[2048 + (lane & 31)];
#pragma unroll
        for (int d = 0; d < 32; ++d) *(LAS unsigned short*)(cL + d * 128 + lane * 2) = (unsigned short)f2bf(Cs[d]);
        if (lane < 32) nsL[lane] = ns;
    }
    __builtin_amdgcn_sched_barrier(0);
    float q[32];
    { float kc[32]; conv_silu32(A.MQK, A.conv_w, 256 + h * 32, row, tseq, kc);
#pragma unroll
      for (int j = 0; j < 4; ++j) { v4u o;
#pragma unroll
          for (int i = 0; i < 4; ++i) o[i] = pk2(kc[8 * j + 2 * i] * 0.17677669529663687f, kc[8 * j + 2 * i + 1] * 0.17677669529663687f);
          *(LAS v4u*)(kL + lane * 64 + 16 * j) = o; } }
    __builtin_amdgcn_sched_barrier(0);
    conv_silu32(A.MQK, A.conv_w, h * 32, row, tseq, q);
    LDS_WAIT(); asm volatile("" ::: "memory"); __builtin_amdgcn_sched_barrier(0);
    float den = 0.f, dinv = 0.f, ss = 0.f;
    {
        float qn = 0.f;
#pragma unroll
        for (int j = 0; j < 8; ++j) { const f32x4 n4 = *(const LAS f32x4*)(nsL + 4 * j); qn += (q[4 * j] * n4.x + q[4 * j + 1] * n4.y) + (q[4 * j + 2] * n4.z + q[4 * j + 3] * n4.w); }
        den = w_inter * qn;
    }
    float acc[32];
#pragma unroll 1
    for (int eh = 0; eh < 2; ++eh) {
        float wint = w_inter; asm volatile("" : "+v"(wint));
        { const GAS v4u* vp = (const GAS v4u*)(A.MV + (size_t)row * 512 + h * 64 + 32 * eh);
#pragma unroll
          for (int j = 0; j < 4; ++j) *(LAS v4u*)(vL + lane * 80 + 16 * j) = vp[j]; }
#pragma unroll
        for (int e = 0; e < 32; ++e) acc[e] = 0.f;
#pragma unroll
        for (int d = 0; d < 32; ++d) { float qd = q[d] * wint; asm volatile("" : "+v"(qd));
#pragma unroll
            for (int j = 0; j < 4; ++j) { const v4u cv = *(const LAS v4u*)(cL + d * 128 + 64 * eh + 16 * j);
#pragma unroll
                for (int i = 0; i < 4; ++i) { fmac_s(acc[8 * j + 2 * i], qd, bflo(cv[i])); fmac_s(acc[8 * j + 2 * i + 1], qd, bfhi(cv[i])); } }
            if ((d & 1) == 1) { asm volatile("" ::: "memory"); __builtin_amdgcn_sched_barrier(0); } }
        LDS_WAIT(); asm volatile("" ::: "memory");
#pragma unroll 1
        for (int s = 0; s < 64; ++s) {
            float qk = 0.f;
#pragma unroll
            for (int j = 0; j < 4; ++j) { const v4u kv = *(const LAS v4u*)(kL + s * 64 + 16 * j);
#pragma unroll
                for (int i = 0; i < 4; ++i) { fmac_s(qk, q[8 * j + 2 * i], bflo(kv[i])); fmac_s(qk, q[8 * j + 2 * i + 1], bfhi(kv[i])); } }
            const float bs = readlane_f(beta, s);
            const float S = (s <= lane) ? qk * __expf(alpha + bs) : 0.f;
            if (eh == 0) den += S;
#pragma unroll
            for (int j = 0; j < 4; ++j) { const v4u vv = *(const LAS v4u*)(vL + s * 80 + 16 * j);
#pragma unroll
                for (int i = 0; i < 4; ++i) { fmac_s(acc[8 * j + 2 * i], S, bflo(vv[i])); fmac_s(acc[8 * j + 2 * i + 1], S, bfhi(vv[i])); } }
        }
        if (eh == 0) dinv = 1.0f / fmaxf(fabsf(den), __expf(-m_t));
#pragma unroll
        for (int e = 0; e < 32; ++e) { acc[e] *= dinv; ss += acc[e] * acc[e]; }
        if (eh == 0) {
#pragma unroll
            for (int j = 0; j < 4; ++j) { v4u o;
#pragma unroll
                for (int i = 0; i < 4; ++i) o[i] = pk2(acc[8 * j + 2 * i], acc[8 * j + 2 * i + 1]);
                *(LAS v4u*)(hL + lane * 64 + 16 * j) = o; }
        }
        LDS_WAIT(); asm volatile("" ::: "memory"); __builtin_amdgcn_sched_barrier(0);
    }
    const float rstd = 1.0f / sqrtf(ss * (1.0f / 64.0f) + NORM_EPS);
    const GAS v4u* mop = (const GAS v4u*)(A.MO + (size_t)row * 512 + h * 64);
    GAS v4u* op = (GAS v4u*)(A.MIX + (size_t)row * DMODEL + 512 + h * 64);
    const float* wn = A.out_norm_w + h * 64;
#pragma unroll
    for (int j = 0; j < 8; ++j) { const v4u mo = mop[j]; v4u o; v4u h0 = (v4u){0u, 0u, 0u, 0u};
        if (j < 4) h0 = *(const LAS v4u*)(hL + lane * 64 + 16 * j);
#pragma unroll
        for (int i = 0; i < 4; ++i) { const float g0 = __builtin_amdgcn_rcpf(1.0f + __expf(-bflo(mo[i]))), g1 = __builtin_amdgcn_rcpf(1.0f + __expf(-bfhi(mo[i])));
            const float a0 = j < 4 ? bflo(h0[i]) : acc[8 * (j & 3) + 2 * i], a1 = j < 4 ? bfhi(h0[i]) : acc[8 * (j & 3) + 2 * i + 1];
            o[i] = pk2(a0 * rstd * wn[8 * j + 2 * i] * g0, a1 * rstd * wn[8 * j + 2 * i + 1] * g1); }
        op[j] = o; asm volatile("" ::: "memory"); __builtin_amdgcn_sched_barrier(0); }
    LDS_WAIT(); asm volatile("" ::: "memory");
}

constexpr int ML_WL2 = 17024;
__device__ __forceinline__ attn_body::bf16x8 ml_pack8(const attn_body::f32x16& P, int b) {
    attn_body::u32x4 w; w[0] = attn_body::cvtpk_s(P[b], P[b + 1]); w[1] = attn_body::cvtpk_s(P[b + 2], P[b + 3]); w[2] = attn_body::cvtpk_s(P[b + 4], P[b + 5]); w[3] = attn_body::cvtpk_s(P[b + 6], P[b + 7]);
    return __builtin_bit_cast(attn_body::bf16x8, w);
}
__device__ __forceinline__ float ml_weight_tile(attn_body::f32x16& P, const LAS float* betaL, int kvb, int hi, int tq, float a_q) {
    float sum = 0.f;
#pragma unroll
    for (int g = 0; g < 4; ++g) { const f32x4 bt = *(const LAS f32x4*)(betaL + 32 * kvb + 8 * g + 4 * hi);
#pragma unroll
        for (int i = 0; i < 4; ++i) { const int kv = 32 * kvb + 8 * g + 4 * hi + i; const float e = (kv <= tq) ? __expf(a_q + bt[i]) : 0.f; P[4 * g + i] *= e; sum += P[4 * g + i]; } }
    return sum;
}
__device__ __forceinline__ void ml_output_item_mfma(const MlArgs& A, int bh, int c, LAS unsigned char* wl, int lane, unsigned long long* tp = nullptr) {
    unsigned long long t0_ = tp ? __builtin_amdgcn_s_memrealtime() : 0ull;
#define MLT(i_) do { if (tp) { const unsigned long long t_ = __builtin_amdgcn_s_memrealtime(); if (threadIdx.x == 0) tp[i_] = t_ - t0_; t0_ = t_; } } while (0)
    using attn_body::f32x16; using attn_body::bf16x8; using attn_body::s16x4; using attn_body::lds_cptr; using attn_body::u32x4;
    asm volatile("" : "+v"(lane));
    const int b = bh >> 3, h = bh & 7; const long row0 = (long)b * SEQ + c * 64, row = row0 + lane; const int tseq = c * 64 + lane;
    const int r32 = lane & 31, hi = lane >> 5;
    LAS unsigned char* kI = wl; LAS unsigned char* qI = wl + 4096; LAS unsigned char* vI = wl + 8192;
    LAS float* betaL = (LAS float*)(wl + 16384); LAS float* dinvL = betaL + 64; LAS float* nsL = dinvL + 64;
    const float fc = A.GATES[(size_t)row * 24 + 16 + h], ic = A.GATES[(size_t)row * 24 + 8 + h];
    const float bcum = wave_scan_sum(fc, lane);
    const float beta = ic - bcum, pmax = wave_scan_max(beta, lane);
    const float* ps = A.MPS + (size_t)(bh * 32 + c) * MST_PITCH;
    const float mprev = ps[2048 + 32];
    const float inter = bcum + mprev, m_t = fmaxf(inter, bcum + pmax), w_inter = __expf(inter - m_t), alpha = bcum - m_t, em = __expf(-m_t);
    betaL[lane] = beta;
    if (lane < 32) nsL[lane] = ps[2048 + lane];
    { float kc[32]; conv_silu32(A.MQK, A.conv_w, 256 + h * 32, row, tseq, kc);
#pragma unroll
      for (int j = 0; j < 4; ++j) { v4u o;
#pragma unroll
          for (int i = 0; i < 4; ++i) o[i] = pk2(kc[8 * j + 2 * i] * 0.17677669529663687f, kc[8 * j + 2 * i + 1] * 0.17677669529663687f);
          *(LAS v4u*)(kI + j * 1024 + lane * 16) = o; } }
    __builtin_amdgcn_sched_barrier(0);
    float den_inter;
    { float q[32]; conv_silu32(A.MQK, A.conv_w, h * 32, row, tseq, q);
#pragma unroll
      for (int j = 0; j < 4; ++j) { v4u o;
#pragma unroll
          for (int i = 0; i < 4; ++i) o[i] = pk2(q[8 * j + 2 * i], q[8 * j + 2 * i + 1]);
          *(LAS v4u*)(qI + j * 1024 + lane * 16) = o; }
      LDS_WAIT(); asm volatile("" ::: "memory");
      float qn = 0.f;
#pragma unroll
      for (int j = 0; j < 8; ++j) { const f32x4 n4 = *(const LAS f32x4*)(nsL + 4 * j); qn += (q[4 * j] * n4.x + q[4 * j + 1] * n4.y) + (q[4 * j + 2] * n4.z + q[4 * j + 3] * n4.w); }
      den_inter = w_inter * qn; }
    { const GAS v4u* vp = (const GAS v4u*)(A.MV + (size_t)row * 512 + h * 64);
#pragma unroll
      for (int j = 0; j < 8; ++j) *(LAS v4u*)(vI + (j >> 2) * 4096 + lane * 64 + (j & 3) * 16) = vp[j]; }
    float Cs[32];
#pragma unroll
    for (int d = 0; d < 32; ++d) Cs[d] = ps[d * 64 + lane];
    LDS_WAIT(); asm volatile("" ::: "memory"); __builtin_amdgcn_sched_barrier(0);
    MLT(0);
    bf16x8 qr[2][2];
#pragma unroll
    for (int tb = 0; tb < 2; ++tb)
#pragma unroll
        for (int d0 = 0; d0 < 2; ++d0) qr[tb][d0] = *(const LAS bf16x8*)(qI + (2 * d0 + hi) * 1024 + (32 * tb + r32) * 16);
    f32x16 p00 = f32x16{}, p10 = f32x16{}, p11 = f32x16{};
#pragma unroll
    for (int d0 = 0; d0 < 2; ++d0) {
        const bf16x8 kf0 = *(const LAS bf16x8*)(kI + (2 * d0 + hi) * 1024 + r32 * 16), kf1 = *(const LAS bf16x8*)(kI + (2 * d0 + hi) * 1024 + (32 + r32) * 16);
        p00 = __builtin_amdgcn_mfma_f32_32x32x16_bf16(kf0, qr[0][d0], p00, 0, 0, 0);
        p10 = __builtin_amdgcn_mfma_f32_32x32x16_bf16(kf0, qr[1][d0], p10, 0, 0, 0);
        p11 = __builtin_amdgcn_mfma_f32_32x32x16_bf16(kf1, qr[1][d0], p11, 0, 0, 0);
    }
    float wq[2];
    bf16x8 pa0[2], pa1[4];
    {
        const int tq = r32; const float a_q = __shfl(alpha, tq);
        float ds = ml_weight_tile(p00, betaL, 0, hi, tq, a_q);
        { auto rr = __builtin_amdgcn_permlane32_swap(__float_as_uint(ds), __float_as_uint(ds), false, false); ds = __uint_as_float(rr[0]) + __uint_as_float(rr[1]); }
        const float den = __shfl(den_inter, tq) + ds, dinv = __builtin_amdgcn_rcpf(fmaxf(fabsf(den), __shfl(em, tq)));
        if (hi == 0) dinvL[tq] = dinv;
        wq[0] = __shfl(w_inter, tq);
        pa0[0] = ml_pack8(p00, 0); pa0[1] = ml_pack8(p00, 8);
    }
    {
        const int tq = 32 + r32; const float a_q = __shfl(alpha, tq);
        float ds = ml_weight_tile(p10, betaL, 0, hi, tq, a_q) + ml_weight_tile(p11, betaL, 1, hi, tq, a_q);
        { auto rr = __builtin_amdgcn_permlane32_swap(__float_as_uint(ds), __float_as_uint(ds), false, false); ds = __uint_as_float(rr[0]) + __uint_as_float(rr[1]); }
        const float den = __shfl(den_inter, tq) + ds, dinv = __builtin_amdgcn_rcpf(fmaxf(fabsf(den), __shfl(em, tq)));
        if (hi == 0) dinvL[tq] = dinv;
        wq[1] = __shfl(w_inter, tq);
        pa1[0] = ml_pack8(p10, 0); pa1[1] = ml_pack8(p10, 8); pa1[2] = ml_pack8(p11, 0); pa1[3] = ml_pack8(p11, 8);
    }
    LDS_WAIT(); asm volatile("" ::: "memory");
#pragma unroll
    for (int j = 0; j < 4; ++j) { v4u o;
#pragma unroll
        for (int i = 0; i < 4; ++i) o[i] = pk2(Cs[8 * j + 2 * i], Cs[8 * j + 2 * i + 1]);
        *(LAS v4u*)(kI + lane * 64 + 16 * j) = o; }
    LDS_WAIT(); asm volatile("" ::: "memory"); __builtin_amdgcn_sched_barrier(0);
    MLT(1);
    f32x16 o[2][2];
    const lds_cptr vb = (lds_cptr)vI + ((lane >> 4) & 1) * 32 + (lane & 3) * 8 + (4 * hi + ((lane & 15) >> 2)) * 64;
#pragma unroll
    for (int tb = 0; tb < 2; ++tb) {
        bf16x8 qw[2];
#pragma unroll
        for (int ks = 0; ks < 2; ++ks) { const u32x4 w = __builtin_bit_cast(u32x4, qr[tb][ks]); u32x4 r;
#pragma unroll
            for (int i = 0; i < 4; ++i) r[i] = attn_body::cvtpk_s(bflo(w[i]) * wq[tb], bfhi(w[i]) * wq[tb]);
            qw[ks] = __builtin_bit_cast(bf16x8, r); }
#pragma unroll
        for (int e0 = 0; e0 < 2; ++e0) {
            f32x16 acc = f32x16{};
#pragma unroll
            for (int ks = 0; ks < 4; ++ks) { if (tb == 0 && ks >= 2) continue;
                const s16x4 lo = attn_body::vtr(vb + e0 * 4096 + ks * 1024), hv = attn_body::vtr(vb + e0 * 4096 + ks * 1024 + 512);
                const bf16x8 vf = (bf16x8){lo[0], lo[1], lo[2], lo[3], hv[0], hv[1], hv[2], hv[3]};
                acc = __builtin_amdgcn_mfma_f32_32x32x16_bf16(tb == 0 ? pa0[ks & 1] : pa1[ks], vf, acc, 0, 0, 0); }
#pragma unroll
            for (int ks = 0; ks < 2; ++ks) { const bf16x8 cf = *(const LAS bf16x8*)(kI + (32 * e0 + r32) * 64 + (16 * ks + 8 * hi) * 2);
                acc = __builtin_amdgcn_mfma_f32_32x32x16_bf16(qw[ks], cf, acc, 0, 0, 0); }
            o[tb][e0] = acc;
        }
    }
    MLT(2);
    const float* wn = A.out_norm_w + h * 64;
#pragma unroll
    for (int tb = 0; tb < 2; ++tb) {
        LDS_WAIT(); asm volatile("" ::: "memory");
        LAS unsigned short* stg = (LAS unsigned short*)kI;
#pragma unroll
        for (int g = 0; g < 4; ++g) { const f32x4 dv = *(const LAS f32x4*)(dinvL + 32 * tb + 8 * g + 4 * hi);
#pragma unroll
            for (int i = 0; i < 4; ++i) { const int orow = 8 * g + 4 * hi + i;
                stg[orow * 64 + r32] = (unsigned short)f2bf(o[tb][0][4 * g + i] * dv[i]); stg[orow * 64 + 32 + r32] = (unsigned short)f2bf(o[tb][1][4 * g + i] * dv[i]); } }
        LDS_WAIT(); asm volatile("" ::: "memory");
#pragma unroll
        for (int i = 0; i < 4; ++i) { const int rl = i * 8 + (lane >> 3), ch = lane & 7; const v4u v = *(const LAS v4u*)(kI + rl * 128 + ch * 16);
            float x[8];
#pragma unroll
            for (int j = 0; j < 4; ++j) { x[2 * j] = bflo(v[j]); x[2 * j + 1] = bfhi(v[j]); }
            float ss = 0.f;
#pragma unroll
            for (int j = 0; j < 8; ++j) ss += x[j] * x[j];
            ss += __shfl_xor(ss, 1); ss += __shfl_xor(ss, 2); ss += __shfl_xor(ss, 4);
            const float rs = __builtin_amdgcn_rsqf(ss * (1.0f / 64.0f) + NORM_EPS);
            const long orow = row0 + 32 * tb + rl;
            const v4u mo = *(const GAS v4u*)(A.MO + (size_t)orow * 512 + h * 64 + ch * 8); v4u ov;
#pragma unroll
            for (int j = 0; j < 4; ++j) { const float g0 = __builtin_amdgcn_rcpf(1.0f + __expf(-bflo(mo[j]))), g1 = __builtin_amdgcn_rcpf(1.0f + __expf(-bfhi(mo[j])));
                ov[j] = pk2(x[2 * j] * rs * wn[ch * 8 + 2 * j] * g0, x[2 * j + 1] * rs * wn[ch * 8 + 2 * j + 1] * g1); }
            *(GAS v4u*)(A.MIX + (size_t)orow * DMODEL + 512 + h * 64 + ch * 8) = ov; }
    }
    LDS_WAIT(); asm volatile("" ::: "memory");
    MLT(3);
#undef MLT
}

struct RtArgs { bf16* x1; const float* x; const float *moe_norm_w, *router_w, *router_b; const bf16 *RWH, *RWL;
                 unsigned char* H2; int* TOPI; float* TOPW; int* HIST; };
__device__ __forceinline__ void p5_router(const RtArgs& A, LAS unsigned char* lds, int vcu, int G, int tid, int lane, int wave, unsigned long long* tp = nullptr, unsigned* ready = nullptr) {
    (void)tp;
    LAS unsigned char* h2L = lds;
    LAS float* logL = (LAS float*)(lds + 131072);
    LAS int* hist = (LAS int*)(lds + 131072 + 64 * 33 * 4);
    f32x4 wn[4];
#pragma unroll
    for (int j = 0; j < 4; ++j) wn[j] = *(const f32x4*)(A.moe_norm_w + 4 * lane + 256 * j);
    for (int seg = vcu; seg < NSEG; seg += G) {
        if (ready) {
            if (tid == 0) { unsigned sp_ = 0; while (__hip_atomic_load(ready + 64 * (seg >> 2), __ATOMIC_RELAXED, __HIP_MEMORY_SCOPE_AGENT) < 32u && ++sp_ < (1u << 22)) __builtin_amdgcn_s_sleep(2); }
            __syncthreads(); }
        if (tid < 32) hist[tid] = 0;
        f32x4 vn[2][4];
#pragma unroll
        for (int u = 0; u < 2; ++u)
#pragma unroll
            for (int j = 0; j < 4; ++j) { const unsigned long long w = ((const GAS unsigned long long*)(A.x1 + (size_t)(seg * 64 + wave * 8 + u) * DMODEL) + lane)[64 * j]; vn[u][j] = ((const GAS f32x4*)(A.x + (size_t)(seg * 64 + wave * 8 + u) * DMODEL) + lane)[64 * j] + (f32x4){bflo((unsigned)w), bfhi((unsigned)w), bflo((unsigned)(w >> 32)), bfhi((unsigned)(w >> 32))}; }
#pragma unroll 1
        for (int i = 0; i < 4; ++i) {
            const int m0 = seg * 64 + wave * 8 + 2 * i;
            f32x4 v[2][4];
#pragma unroll
            for (int u = 0; u < 2; ++u)
#pragma unroll
                for (int j = 0; j < 4; ++j) v[u][j] = vn[u][j];
            if (i < 3) {
#pragma unroll
                for (int u = 0; u < 2; ++u)
#pragma unroll
                    for (int j = 0; j < 4; ++j) { const unsigned long long w = ((const GAS unsigned long long*)(A.x1 + (size_t)(m0 + 2 + u) * DMODEL) + lane)[64 * j]; vn[u][j] = ((const GAS f32x4*)(A.x + (size_t)(m0 + 2 + u) * DMODEL) + lane)[64 * j] + (f32x4){bflo((unsigned)w), bfhi((unsigned)w), bflo((unsigned)(w >> 32)), bfhi((unsigned)(w >> 32))}; }
            }
#pragma unroll
            for (int u = 0; u < 2; ++u) {
                float s = 0.f;
#pragma unroll
                for (int j = 0; j < 4; ++j) { s += (v[u][j].x * v[u][j].x + v[u][j].y * v[u][j].y) + (v[u][j].z * v[u][j].z + v[u][j].w * v[u][j].w); }
                const float rstd = 1.f / sqrtf(wave_sum(s) * (1.f / DMODEL) + NORM_EPS);
                { GAS unsigned long long* x8 = (GAS unsigned long long*)(A.x1 + (size_t)(m0 + u) * DMODEL) + lane;
#pragma unroll
                  for (int j = 0; j < 4; ++j) x8[64 * j] = (unsigned long long)pk2(v[u][j].x, v[u][j].y) | ((unsigned long long)pk2(v[u][j].z, v[u][j].w) << 32); }
                GAS unsigned* o4 = (GAS unsigned*)(A.H2 + (size_t)(m0 + u) * DMODEL) + lane;
                const int rl = wave * 8 + 2 * i + u;
#pragma unroll
                for (int j = 0; j < 4; ++j) { v[u][j] = v[u][j] * rstd * wn[j]; int pk = __builtin_amdgcn_cvt_pk_fp8_f32(v[u][j].x, v[u][j].y, 0, false); pk = __builtin_amdgcn_cvt_pk_fp8_f32(v[u][j].z, v[u][j].w, pk, true); o4[64 * j] = (unsigned)pk;
                    const int ch = (lane >> 1) + 32 * j;
                    *(LAS unsigned long long*)(h2L + rl * 2048 + ((ch ^ (rl & 15)) << 4) + (lane & 1) * 8) = (unsigned long long)pk2(v[u][j].x, v[u][j].y) | ((unsigned long long)pk2(v[u][j].z, v[u][j].w) << 32); }
            }
        }
        __syncthreads();
        if (TS_PHASE == 150 && tp && tid == 0) *tp = rt();
        {
            const int r32 = lane & 31, hi = lane >> 5;
            attn_body::f32x16 acc0 = attn_body::f32x16{}, acc1 = attn_body::f32x16{};
            const bf16* wh = A.RWH + (size_t)r32 * DMODEL + 128 * wave + 8 * hi; const bf16* wl = A.RWL + (size_t)r32 * DMODEL + 128 * wave + 8 * hi;
            attn_body::bf16x8 bh[8], bl[8];
#pragma unroll
            for (int ks = 0; ks < 8; ++ks) { bh[ks] = *(const GAS attn_body::bf16x8*)(wh + 16 * ks); bl[ks] = *(const GAS attn_body::bf16x8*)(wl + 16 * ks); }
#pragma unroll
            for (int ks = 0; ks < 8; ++ks) {
                const int ch = 2 * (8 * wave + ks) + hi;
                const attn_body::bf16x8 a0 = *(const LAS attn_body::bf16x8*)(h2L + r32 * 2048 + ((ch ^ (r32 & 15)) << 4));
                const attn_body::bf16x8 a1 = *(const LAS attn_body::bf16x8*)(h2L + (32 + r32) * 2048 + ((ch ^ (r32 & 15)) << 4));
                acc0 = __builtin_amdgcn_mfma_f32_32x32x16_bf16(a0, bh[ks], acc0, 0, 0, 0); acc1 = __builtin_amdgcn_mfma_f32_32x32x16_bf16(a1, bh[ks], acc1, 0, 0, 0);
                acc0 = __builtin_amdgcn_mfma_f32_32x32x16_bf16(a0, bl[ks], acc0, 0, 0, 0); acc1 = __builtin_amdgcn_mfma_f32_32x32x16_bf16(a1, bl[ks], acc1, 0, 0, 0);
            }
            __syncthreads();
            LAS float* part = (LAS float*)lds + wave * (64 * 33);
#pragma unroll
            for (int r = 0; r < 16; ++r) { const int tr = (r & 3) + 8 * (r >> 2) + 4 * hi; part[tr * 33 + r32] = acc0[r]; part[(32 + tr) * 33 + r32] = acc1[r]; }
        }
        __syncthreads();
#pragma unroll
        for (int i = 0; i < 4; ++i) { const int o = tid + 512 * i, tk = o >> 5, e = o & 31; float sacc = A.router_b[e];
#pragma unroll
            for (int w = 0; w < 8; ++w) sacc += ((const LAS float*)lds)[w * (64 * 33) + tk * 33 + e];
            logL[tk * 33 + e] = sacc; }
        __syncthreads();
        if (TS_PHASE == 151 && tp && tid == 0) *tp = rt();
        if (wave == 0) {
            float v[32];
#pragma unroll
            for (int e = 0; e < 32; ++e) v[e] = logL[lane * 33 + e];
            int te[4]; float tv[4];
#pragma unroll
            for (int k = 0; k < 4; ++k) {
                float mx = v[0];
#pragma unroll
                for (int e = 1; e < 32; ++e) mx = fmaxf(mx, v[e]);
                int idx = 31;
#pragma unroll
                for (int e = 30; e >= 0; --e) idx = (v[e] == mx) ? e : idx;
                tv[k] = mx; te[k] = idx;
#pragma unroll
                for (int e = 0; e < 32; ++e) v[e] = (e == idx) ? -3.0e38f : v[e];
            }
            const float e1 = __expf(tv[1] - tv[0]), e2 = __expf(tv[2] - tv[0]), e3 = __expf(tv[3] - tv[0]), inv = __builtin_amdgcn_rcpf(1.0f + e1 + e2 + e3);
            const int m = seg * 64 + lane;
            *(int4*)(A.TOPI + (size_t)m * 4) = make_int4(te[0], te[1], te[2], te[3]);
            *(float4*)(A.TOPW + (size_t)m * 4) = make_float4(inv, e1 * inv, e2 * inv, e3 * inv);
#pragma unroll
            for (int k = 0; k < 4; ++k) __hip_atomic_fetch_add(hist + te[k], 1, __ATOMIC_RELAXED, __HIP_MEMORY_SCOPE_WORKGROUP);
        }
        __syncthreads();
        if (tid < 32) A.HIST[seg * 32 + tid] = hist[tid];
        __syncthreads();
    }
}

struct DsArgs { const int* TOPI; const float* TOPW; const int* HIST; int* POSSLOT; int* TOKPOS; float* GATEPOS; int* TILEPREF; };
__device__ __forceinline__ void p6_dispatch(const DsArgs& A, LAS unsigned char* lds, int vcu, int G, int tid) {
    LAS int* pb = (LAS int*)lds;
    LAS int* pt = pb + 512;
    LAS int* nE = pt + 512;
    LAS int* base = nE + 32;
    LAS int* pst = base + 32;
    LAS int* es = pst + 64;
    LAS int* wc = es + 256;
    for (int seg = vcu; seg < NSEG; seg += G) {
        { const int e = tid & 31, j = tid >> 5; int below = 0, tot = 0;
          for (int s = 16 * j; s < 16 * j + 16; ++s) { const int hv = A.HIST[s * 32 + e]; tot += hv; if (s < seg) below += hv; }
          pb[j * 32 + e] = below; pt[j * 32 + e] = tot; }
        if (tid < 256) es[tid] = A.TOPI[(size_t)seg * 256 + tid];
        __syncthreads();
        if (tid < 32) { int n = 0, o = 0; for (int j = 0; j < 16; ++j) { n += pt[j * 32 + tid]; o += pb[j * 32 + tid]; } nE[tid] = n; base[tid] = o; }
        __syncthreads();
        if (tid < 32) { int ps = 0; for (int e = 0; e < tid; ++e) ps += (nE[e] + 255) >> 8; pst[tid] = ps * 256; base[tid] += ps * 256;
                        if (tid == 31) pst[32] = (ps + ((nE[31] + 255) >> 8)) * 256; }
        __syncthreads();
        int rkw = 0;
        if (tid < 256) {
            const int e = es[tid]; const int lane_ = tid & 63, w_ = tid >> 6;
#pragma unroll 4
            for (int q = 0; q < NE; ++q) { const unsigned long long bq = __ballot(e == q); if (e == q) rkw = __popcll(bq & ((1ull << lane_) - 1ull)); if (lane_ == 0) wc[w_ * 32 + q] = __popcll(bq); }
        }
        __syncthreads();
        if (tid < 256) {
            const int e = es[tid]; int rank = rkw;
            for (int w = 0; w < (tid >> 6); ++w) rank += wc[w * 32 + e];
            const int pos = base[e] + rank, slot = seg * 256 + tid;
            A.POSSLOT[slot] = pos; A.TOKPOS[pos] = slot >> 2; A.GATEPOS[pos] = A.TOPW[slot];
        }
        if (seg == 0 && tid <= 32) A.TILEPREF[tid] = pst[tid] >> 8;
        if (seg == 0 && tid < NE) {
            const int m = (nE[tid] + 255) >> 8; int k = 0;
            for (int e = 0; e < NE; ++e) { const int me = (nE[e] + 255) >> 8; k += (me > m || (me == m && e < tid)) ? 1 : 0; }
            const int j = k >> 3, g = (j & 1) ? 7 - (k & 7) : (k & 7); A.TILEPREF[33 + g + 8 * j] = tid;
        }
        if (seg < NE) { const int e = seg, p0 = pst[e] + nE[e], p1 = pst[e + 1];
            for (int p = p0 + tid; p < p1; p += NWAVES * 64) { A.TOKPOS[p] = 0; A.GATEPOS[p] = 0.f; } }
        __syncthreads();
    }
}

template <int K> __device__ __forceinline__ float f8b(unsigned w) { return __builtin_amdgcn_cvt_f32_fp8((int)w, K); }
__device__ __forceinline__ void p9_combine(float* out, const bf16* X1, const unsigned char* Y, const int* POSSLOT, int vcu, int G, int lane, int wave) {
    const int gw = vcu * NWAVES + wave, NGW = G * NWAVES;
    for (int m0 = gw; m0 < MTOK; m0 += 4 * NGW) {
        int4 ps[4];
#pragma unroll
        for (int i = 0; i < 4; ++i) { const int m = m0 + i * NGW; ps[i] = (m < MTOK) ? *(const int4*)(POSSLOT + (size_t)m * 4) : make_int4(0, 0, 0, 0); }
#pragma unroll
        for (int i = 0; i < 4; ++i) {
            const int m = m0 + i * NGW; if (m >= MTOK) break;
            GAS f32x4* xr = (GAS f32x4*)(out + (size_t)m * DMODEL) + lane;
            const GAS unsigned long long* x1r = (const GAS unsigned long long*)(X1 + (size_t)m * DMODEL) + lane;
            const GAS unsigned* y0 = (const GAS unsigned*)(Y + (size_t)ps[i].x * DMODEL) + lane;
            const GAS unsigned* y1 = (const GAS unsigned*)(Y + (size_t)ps[i].y * DMODEL) + lane;
            const GAS unsigned* y2 = (const GAS unsigned*)(Y + (size_t)ps[i].z * DMODEL) + lane;
            const GAS unsigned* y3 = (const GAS unsigned*)(Y + (size_t)ps[i].w * DMODEL) + lane;
            unsigned long long xw[4]; unsigned a[4], b[4], c[4], d[4];
#pragma unroll
            for (int j = 0; j < 4; ++j) { xw[j] = x1r[64 * j]; a[j] = y0[64 * j]; b[j] = y1[64 * j]; c[j] = y2[64 * j]; d[j] = y3[64 * j]; }
#pragma unroll
            for (int j = 0; j < 4; ++j) {
                f32x4 v = (f32x4){bflo((unsigned)xw[j]), bfhi((unsigned)xw[j]), bflo((unsigned)(xw[j] >> 32)), bfhi((unsigned)(xw[j] >> 32))};
                v.x += (f8b<0>(a[j]) + f8b<0>(b[j])) + (f8b<0>(c[j]) + f8b<0>(d[j]));
                v.y += (f8b<1>(a[j]) + f8b<1>(b[j])) + (f8b<1>(c[j]) + f8b<1>(d[j]));
                v.z += (f8b<2>(a[j]) + f8b<2>(b[j])) + (f8b<2>(c[j]) + f8b<2>(d[j]));
                v.w += (f8b<3>(a[j]) + f8b<3>(b[j])) + (f8b<3>(c[j]) + f8b<3>(d[j]));
                xr[64 * j] = v;
            }
        }
    }
}

struct Args { const float* in[19]; float* out; unsigned char* ws; int ph_lo, ph_hi, li, pad; };
__global__ void __launch_bounds__(NWAVES * 64, 2) hymba_fwd(Args args) {
    extern __shared__ __attribute__((aligned(16))) unsigned char lds_raw[];
    LAS unsigned char* lds = (LAS unsigned char*)lds_raw;
    volatile LAS unsigned* MISC = (volatile LAS unsigned*)(lds + MISC_OFF);
    const int tid0 = threadIdx.x, wave = __builtin_amdgcn_readfirstlane(tid0 >> 6);
#define PHASE_TID() int tid = tid0; asm volatile("" : "+v"(tid)); const int lane = tid & 63; (void)lane
    const int G = gridDim.x; int vcu = (G % 8 == 0) ? ((int)blockIdx.x % 8) * (G / 8) + (int)blockIdx.x / 8 : (int)blockIdx.x;
    bool xcd_known = false;
    int cvirt = (int)blockIdx.x;
    unsigned char* ws = args.ws;
    gu32* ctl = (gu32*)(ws + WS_CTL);
    for (int u = tid0; u < (LDS_BYTES - LDSCTL_OFF) / 4; u += NWAVES * 64) ((LAS unsigned*)(lds + LDSCTL_OFF))[u] = 0u;
    __syncthreads();
    XcdBarrier bar; bar.bar = (unsigned*)(ctl + CW_BAR); bar.x = 0; bar.st = nullptr;
    if (N_LAUNCHES == 1) bar = xcd_barrier_post((unsigned*)(ctl + CW_BAR), MISC + 8);
#define GRID_BAR() do { if (N_LAUNCHES == 1) xcd_barrier(bar); } while (0)
    const int lo = args.ph_lo, hi = args.ph_hi;
#ifndef PHASE_MASK
#define PHASE_MASK 0x3ff
#endif
#define IN(k) (((PHASE_MASK >> (k)) & 1) && lo <= (k) && (k) < hi)
#define BOTH(k) (IN(k) && IN((k) + 1))
#ifndef REPEAT_PHASE
#define REPEAT_PHASE -1
#endif
#define NREP(k) ((k) == REPEAT_PHASE ? 2 : 1)
#ifndef TS_PHASE
#define TS_PHASE -1
#endif
#ifndef TS_SCALE
#define TS_SCALE 1.0f
#endif
    unsigned long long ts_prev = 0ull, ts_val = 0ull; int ts_n = 0;
#ifndef CLK_PHASE
#define CLK_PHASE -1
#endif
    unsigned long long ck_prev = 0ull; float clk_val = 0.f;
    unsigned long long ts_first = 0ull;
#define STAMP() do { if (TS_PHASE >= 0) { const unsigned long long t_ = rt(); if (CLK_PHASE >= 0) { const unsigned long long c_ = __builtin_amdgcn_s_memtime(); if (ts_n == CLK_PHASE + 1) clk_val = (float)(c_ - ck_prev) / (float)(t_ - ts_prev) * 1.0f; ck_prev = c_; } if (ts_n == 0) ts_first = t_; if (ts_n == TS_PHASE + 1) ts_val = t_ - ts_prev; if (TS_PHASE == 99 && ts_n == 10) ts_val = t_ - ts_first; ts_prev = t_; ++ts_n; } } while (0)
    STAMP();
    const float* x = args.in[0];
    bf16* WIN = (bf16*)(ws + WS_WIN); bf16* WOUT = (bf16*)(ws + WS_WOUT); unsigned char* WGU = ws + WS_WGU; unsigned char* WD = ws + WS_WD;
    bf16* XN = (bf16*)(ws + WS_XN); bf16* T6 = (bf16*)(ws + WS_T6); bf16* MIX = (bf16*)(ws + WS_MIX);
    float* GATES = (float*)(ws + WS_GATES); float* KBIAS = (float*)(ws + WS_KBIAS); float* MST = (float*)(ws + WS_MST);
    unsigned char* rt_ = ws + WS_ROUTE;
    int* TOPI = (int*)(rt_ + RT_TOPI); float* TOPW = (float*)(rt_ + RT_TOPW); int* HIST = (int*)(rt_ + RT_HIST); int* POSSLOT = (int*)(rt_ + RT_POSSLOT);
    int* TOKPOS = (int*)(rt_ + RT_TOKPOS); float* GATEPOS = (float*)(rt_ + RT_GATEPOS); int* TILEPREF = (int*)(rt_ + RT_TILEPREF);
    unsigned char* ACT = ws + WS_ACT; unsigned char* Y = ws + WS_Y; bf16* X1B = (bf16*)(ws + WS_X1B);
    const MlArgs ML{T6 + 3 * (T6_STRIDE / 2), T6 + 4 * (T6_STRIDE / 2), T6 + 5 * (T6_STRIDE / 2), GATES, args.in[7], args.in[10], MST, MIX, KBIAS, (float*)(ws + WS_MPS), (float*)(ws + WS_ROUTE + 2304 * 1024)};

    if (IN(0)) { for (int rep_ = 0; rep_ < NREP(0); ++rep_) {
        PHASE_TID();
        const P0Args A{x, args.in[1], args.in[2], args.in[3], args.in[8], args.in[9], args.in[11], args.in[15], args.in[17], WIN, WOUT, WGU, WD, XN, GATES, KBIAS, args.in[13], (bf16*)(ws + WS_RW), (unsigned*)(ctl + 2048)};
        const unsigned long long tsx_ = p0_prologue(A, lds, vcu, G, tid, lane, wave, 0);
        const bool split0 = (N_LAUNCHES == 1) && BOTH(0);
        if (split0) xcd_event_post(bar, (unsigned*)(ctl + 10240)); else __syncthreads();
        (void)p0_prologue(A, lds, vcu, G, tid, lane, wave, 1);
        if (TS_PHASE >= 100 && TS_PHASE <= 103 && blockIdx.x == 0 && tid0 == 0) *(volatile unsigned long long*)(ws + WS_CTL + 320 * 1024) = (TS_PHASE == 103 ? rt() : tsx_) - ts_prev;
        if ((TS_PHASE >= 104 && TS_PHASE <= 107) && tid0 == 0) { ((volatile unsigned long long*)(ws + WS_CTL + 328 * 1024))[blockIdx.x] = (TS_PHASE >= 106) ? tsx_ : rt(); __threadfence(); }
        if (split0) xcd_event_wait(bar, (unsigned*)(ctl + 10240)); else if (BOTH(0)) GRID_BAR();
        if ((TS_PHASE >= 104 && TS_PHASE <= 107) && blockIdx.x == 0 && tid0 == 0) { unsigned long long mx = 0ull, mn = ~0ull; for (int b_ = 0; b_ < G; ++b_) { const unsigned long long v_ = __hip_atomic_load((unsigned long long*)(ws + WS_CTL + 328 * 1024) + b_, __ATOMIC_RELAXED, __HIP_MEMORY_SCOPE_AGENT); mx = v_ > mx ? v_ : mx; mn = v_ < mn ? v_ : mn; }
            *(volatile unsigned long long*)(ws + WS_CTL + 320 * 1024) = ((TS_PHASE & 1) == 0 ? mx : mn) - ts_prev; }
        if (N_LAUNCHES == 1 && BOTH(0) && G % 8 == 0) {
            bool even = true;
            for (int j = 0; j < 16; ++j) { const unsigned cj = xb_ld(&bar.bar[XB_XCNT(j)]); even = even && (j < 8 ? cj == (unsigned)(G / 8) : cj == 0u); }
            if (even) { const int rk = (int)MISC[10], xx = (int)MISC[11]; vcu = xx * (G / 8) + rk; cvirt = rk * 8 + xx; xcd_known = true; }
        }
    } STAMP(); }
    bool p45 = false, p34 = false, p12 = false;
    if (IN(1)) { for (int rep_ = 0; rep_ < NREP(1); ++rep_) {
        pg8::Gemm g{XN, WIN, DMODEL, nullptr, nullptr, 0u}; pg8::StaticOrder S; S.init(MTOK, 3072, G, cvirt);
        p12 = xcd_known && G == 256 && BOTH(1);
        pg8::EpiInProj E{T6, T6_STRIDE / 2, args.in[4], args.in[5], p12 ? (unsigned*)ctl : nullptr};
        pg8::gemm_phase<pg8::EpiInProj, pg8::StaticOrder, true, false>(lds, g, S, E);
        if (TS_PHASE == 201 && tid0 == 0) { ((volatile unsigned long long*)(ws + WS_CTL + 328 * 1024))[blockIdx.x] = rt(); __threadfence(); }
        if (BOTH(1) && !p12) GRID_BAR(); else __syncthreads();
        if (TS_PHASE == 201 && blockIdx.x == 0 && tid0 == 0) { unsigned long long mx = 0ull, mn = ~0ull; for (int b_ = 0; b_ < G; ++b_) { const unsigned long long v_ = __hip_atomic_load((unsigned long long*)(ws + WS_CTL + 328 * 1024) + b_, __ATOMIC_RELAXED, __HIP_MEMORY_SCOPE_AGENT); mx = v_ > mx ? v_ : mx; mn = v_ < mn ? v_ : mn; } *(volatile unsigned long long*)(ws + WS_CTL + 320 * 1024) = mx - mn; }
    } STAMP(); }
    unsigned* cnt2 = (unsigned*)ctl + 2304;
    const bool p23 = p12 && BOTH(2);
    if (IN(2)) { for (int rep_ = 0; rep_ < NREP(2); ++rep_) {
        PHASE_TID();
        LAS unsigned char* wl = lds + wave * 17920;
        for (int it = vcu * NWAVES + wave; it < 2048; it += G * NWAVES) {
            const int bh = it >> 5, c = it & 31;
            if (p12) {
                const int pm = (bh >> 3) * 8 + (c >> 2); unsigned sp_ = 0;
                while (__hip_atomic_load((unsigned*)ctl + 32 * pm, __ATOMIC_RELAXED, __HIP_MEMORY_SCOPE_AGENT) < 96u && ++sp_ < (1u << 22)) __builtin_amdgcn_s_sleep(2);
                if ((c & 3) == 0 && c > 0) { sp_ = 0; while (__hip_atomic_load((unsigned*)ctl + 32 * (pm - 1), __ATOMIC_RELAXED, __HIP_MEMORY_SCOPE_AGENT) < 96u && ++sp_ < (1u << 22)) __builtin_amdgcn_s_sleep(2); }
                asm volatile("" ::: "memory");
            }
            ml_local_item(ML, bh, c, wl, lane);
            if (p23) { asm volatile("s_waitcnt vmcnt(0)" ::: "memory"); if (lane == 0) __hip_atomic_fetch_add(cnt2 + 16 * bh, 1u, __ATOMIC_RELAXED, __HIP_MEMORY_SCOPE_AGENT); }
        }
        if (TS_PHASE == 202 && tid0 == 0) { ((volatile unsigned long long*)(ws + WS_CTL + 328 * 1024))[blockIdx.x] = rt(); __threadfence(); }
        if ((TS_PHASE == 212 || TS_PHASE == 222 || TS_PHASE == 232) && tid0 == 0) { ((volatile unsigned long long*)(ws + WS_CTL + 328 * 1024))[blockIdx.x] = rt(); __threadfence(); }
        if (BOTH(2) && !p23) GRID_BAR(); else __syncthreads();
        if ((TS_PHASE == 212 || TS_PHASE == 222 || TS_PHASE == 232) && blockIdx.x == 0 && tid0 == 0) { unsigned long long mx = 0ull, mn = ~0ull; int imx = 0, cnt = 0; unsigned long long sum = 0ull;
            for (int b_ = 0; b_ < G; ++b_) { const unsigned long long v_ = __hip_atomic_load((unsigned long long*)(ws + WS_CTL + 328 * 1024) + b_, __ATOMIC_RELAXED, __HIP_MEMORY_SCOPE_AGENT); if (v_ > mx) { mx = v_; imx = b_; } mn = v_ < mn ? v_ : mn; }
            for (int b_ = 0; b_ < G; ++b_) { const unsigned long long v_ = __hip_atomic_load((unsigned long long*)(ws + WS_CTL + 328 * 1024) + b_, __ATOMIC_RELAXED, __HIP_MEMORY_SCOPE_AGENT); cnt += (v_ > mn + 600ull) ? 1 : 0; sum += v_ - mn; }
            *(volatile unsigned long long*)(ws + WS_CTL + 320 * 1024) = (TS_PHASE == 212) ? (unsigned long long)imx * 100ull : (TS_PHASE == 222 ? (unsigned long long)cnt * 100ull : sum / (unsigned long long)G); }
        if (TS_PHASE == 202 && blockIdx.x == 0 && tid0 == 0) { unsigned long long mx = 0ull, mn = ~0ull; for (int b_ = 0; b_ < G; ++b_) { const unsigned long long v_ = __hip_atomic_load((unsigned long long*)(ws + WS_CTL + 328 * 1024) + b_, __ATOMIC_RELAXED, __HIP_MEMORY_SCOPE_AGENT); mx = v_ > mx ? v_ : mx; mn = v_ < mn ? v_ : mn; } *(volatile unsigned long long*)(ws + WS_CTL + 320 * 1024) = mx - mn; }
    } STAMP(); }
    if (IN(3)) { for (int rep_ = 0; rep_ < NREP(3); ++rep_) {
        const attn_body::AttnTensors AT{(const attn_body::bf16*)T6, (const attn_body::bf16*)(T6 + T6_STRIDE / 2), (const attn_body::bf16*)(T6 + 2 * (T6_STRIDE / 2)), (attn_body::bf16*)MIX, ML.KBF, args.in[6]};
        { PHASE_TID(); for (int it = vcu * NWAVES + wave; it < 64 * 32; it += G * NWAVES) {
              if (p23) { unsigned sp_ = 0; while (__hip_atomic_load(cnt2 + 16 * (it >> 5), __ATOMIC_RELAXED, __HIP_MEMORY_SCOPE_AGENT) < 32u && ++sp_ < (1u << 22)) __builtin_amdgcn_s_sleep(2); asm volatile("" ::: "memory"); }
              ml_scan_item(ML, it >> 5, it & 31, lane);
              if (p23) { asm volatile("s_waitcnt vmcnt(0)" ::: "memory"); if (lane == 0) __hip_atomic_fetch_add(cnt2 + 16 * (it >> 5) + 8, 1u, __ATOMIC_RELAXED, __HIP_MEMORY_SCOPE_AGENT); } } }
        if (N_LAUNCHES == 1 && !p23) xcd_event_post(bar, (unsigned*)(ctl + 8192)); else __syncthreads();
        if (TS_PHASE == 31) { ts_val = rt() - ts_prev; }
        const attn_body::StaticOrder S(G, vcu);
        p34 = xcd_known && G == 256 && BOTH(3);
        unsigned* cnt3 = (unsigned*)(ctl + 36864);
        attn_body::attn_phase<attn_body::StaticOrder>((char*)lds_raw, AT, S, p34 ? cnt3 : nullptr, p23 ? cnt2 : nullptr, p23 ? (const unsigned*)ctl : nullptr);
        __syncthreads();
        if (TS_PHASE == 30) { ts_val = rt() - ts_prev; }
        if (N_LAUNCHES == 1 && !p23) xcd_event_wait(bar, (unsigned*)(ctl + 8192));
        if (TS_PHASE == 32) { ts_val = rt() - ts_prev; }
        PHASE_TID();
        LAS unsigned char* wl = lds + wave * ML_WL2;
        for (int v = vcu; v < 256; v += G) {
            const int pair = v & 15, bh = (v >> 4) * 4 + (wave >> 1), c = (wave & 1) ? 31 - pair : pair;
            if (p23) { const int pm = (bh >> 3) * 8 + (c >> 2); unsigned sp_ = 0;
                while (__hip_atomic_load(cnt2 + 16 * bh + 8, __ATOMIC_RELAXED, __HIP_MEMORY_SCOPE_AGENT) < 32u && ++sp_ < (1u << 22)) __builtin_amdgcn_s_sleep(2);
                sp_ = 0;
                while (__hip_atomic_load((unsigned*)ctl + 32 * pm, __ATOMIC_RELAXED, __HIP_MEMORY_SCOPE_AGENT) < 96u && ++sp_ < (1u << 22)) __builtin_amdgcn_s_sleep(2);
                if ((c & 3) == 0 && c > 0) { sp_ = 0; while (__hip_atomic_load((unsigned*)ctl + 32 * (pm - 1), __ATOMIC_RELAXED, __HIP_MEMORY_SCOPE_AGENT) < 96u && ++sp_ < (1u << 22)) __builtin_amdgcn_s_sleep(2); }
                asm volatile("" ::: "memory"); }
            ml_output_item_mfma(ML, bh, c, wl, lane, (TS_PHASE >= 60 && TS_PHASE <= 63 && blockIdx.x == 0 && wave == 0) ? (unsigned long long*)(ws + WS_CTL + 320 * 1024) : nullptr);
            if (TS_PHASE >= 60 && TS_PHASE <= 63 && blockIdx.x == 0) { __syncthreads(); ts_val = ((volatile unsigned long long*)(ws + WS_CTL + 320 * 1024))[TS_PHASE - 60]; }
            if (p34) { asm volatile("s_waitcnt vmcnt(0)" ::: "memory"); if (lane == 0) __hip_atomic_fetch_add(cnt3 + 64 * ((bh >> 3) * 8 + (c >> 2)), 1u, __ATOMIC_RELAXED, __HIP_MEMORY_SCOPE_AGENT); }
        }
        if (TS_PHASE == 203 && tid0 == 0) { ((volatile unsigned long long*)(ws + WS_CTL + 328 * 1024))[blockIdx.x] = rt(); __threadfence(); }
        if (BOTH(3) && !p34) GRID_BAR(); else __syncthreads();
        if (TS_PHASE == 203 && blockIdx.x == 0 && tid0 == 0) { unsigned long long mx = 0ull, mn = ~0ull; for (int b_ = 0; b_ < G; ++b_) { const unsigned long long v_ = __hip_atomic_load((unsigned long long*)(ws + WS_CTL + 328 * 1024) + b_, __ATOMIC_RELAXED, __HIP_MEMORY_SCOPE_AGENT); mx = v_ > mx ? v_ : mx; mn = v_ < mn ? v_ : mn; } *(volatile unsigned long long*)(ws + WS_CTL + 320 * 1024) = mx - mn; }
    } STAMP(); }
    if (IN(4)) { for (int rep_ = 0; rep_ < NREP(4); ++rep_) {
        pg8::Gemm g{MIX, WOUT, DMODEL, nullptr, (const unsigned*)(ctl + 36864), p34 ? 96u : 0u}; pg8::StaticOrder S; S.init(MTOK, DMODEL, G, cvirt);
        p45 = xcd_known && G == 256 && BOTH(4);
        pg8::EpiResid E{X1B, DMODEL, p45 ? (unsigned*)(ctl + 12288) : nullptr};
        pg8::gemm_phase<pg8::EpiResid, pg8::StaticOrder, true, false, false, true>(lds, g, S, E);
        if (TS_PHASE == 204 && tid0 == 0) { ((volatile unsigned long long*)(ws + WS_CTL + 328 * 1024))[blockIdx.x] = rt(); __threadfence(); }
        if (BOTH(4) && !p45) GRID_BAR();
        if (TS_PHASE == 204 && blockIdx.x == 0 && tid0 == 0) { unsigned long long mx = 0ull, mn = ~0ull; for (int b_ = 0; b_ < G; ++b_) { const unsigned long long v_ = __hip_atomic_load((unsigned long long*)(ws + WS_CTL + 328 * 1024) + b_, __ATOMIC_RELAXED, __HIP_MEMORY_SCOPE_AGENT); mx = v_ > mx ? v_ : mx; mn = v_ < mn ? v_ : mn; } *(volatile unsigned long long*)(ws + WS_CTL + 320 * 1024) = mx - mn; }
    } STAMP(); }
    if (IN(5)) { for (int rep_ = 0; rep_ < NREP(5); ++rep_) {
        PHASE_TID();
        const RtArgs A{X1B, x, args.in[12], args.in[13], args.in[14], (const bf16*)(ws + WS_RW), (const bf16*)(ws + WS_RW + 65536), (unsigned char*)XN, TOPI, TOPW, HIST};
        p5_router(A, lds, vcu, G, tid, lane, wave, (TS_PHASE == 150 || TS_PHASE == 151) && blockIdx.x == 0 ? (unsigned long long*)(ws + WS_CTL + 320 * 1024) : nullptr, p45 ? (unsigned*)(ctl + 12288) : nullptr);
        if ((TS_PHASE == 150 || TS_PHASE == 151) && blockIdx.x == 0 && tid0 == 0) { *(volatile unsigned long long*)(ws + WS_CTL + 320 * 1024) -= ts_prev; }
        if (TS_PHASE == 205 && tid0 == 0) { ((volatile unsigned long long*)(ws + WS_CTL + 328 * 1024))[blockIdx.x] = rt(); __threadfence(); }
        if (BOTH(5)) GRID_BAR();
        if (TS_PHASE == 205 && blockIdx.x == 0 && tid0 == 0) { unsigned long long mx = 0ull, mn = ~0ull; for (int b_ = 0; b_ < G; ++b_) { const unsigned long long v_ = __hip_atomic_load((unsigned long long*)(ws + WS_CTL + 328 * 1024) + b_, __ATOMIC_RELAXED, __HIP_MEMORY_SCOPE_AGENT); mx = v_ > mx ? v_ : mx; mn = v_ < mn ? v_ : mn; } *(volatile unsigned long long*)(ws + WS_CTL + 320 * 1024) = mx - mn; }
    } STAMP(); }
    if (IN(6)) { for (int rep_ = 0; rep_ < NREP(6); ++rep_) {
        PHASE_TID();
        const DsArgs A{TOPI, TOPW, HIST, POSSLOT, TOKPOS, GATEPOS, TILEPREF};
        p6_dispatch(A, lds, vcu, G, tid);
        if (TS_PHASE == 206 && tid0 == 0) { ((volatile unsigned long long*)(ws + WS_CTL + 328 * 1024))[blockIdx.x] = rt(); __threadfence(); }
        if (BOTH(6)) GRID_BAR();
        if (TS_PHASE == 206 && blockIdx.x == 0 && tid0 == 0) { unsigned long long mx = 0ull, mn = ~0ull; for (int b_ = 0; b_ < G; ++b_) { const unsigned long long v_ = __hip_atomic_load((unsigned long long*)(ws + WS_CTL + 328 * 1024) + b_, __ATOMIC_RELAXED, __HIP_MEMORY_SCOPE_AGENT); mx = v_ > mx ? v_ : mx; mn = v_ < mn ? v_ : mn; } *(volatile unsigned long long*)(ws + WS_CTL + 320 * 1024) = mx - mn; }
    } STAMP(); }
    if (IN(7)) { for (int rep_ = 0; rep_ < NREP(7); ++rep_) {
        pg8::Gemm g{XN, (const bf16*)WGU, DMODEL / 2, TOKPOS, nullptr, 0u}; if (TS_PHASE == 70) g.tprobe = (unsigned long long*)(ws + WS_CTL + 200 * 1024) + blockIdx.x; pg8::MoeOrder S; S.init(TILEPREF, 8, G, cvirt, 0, (volatile LAS int*)(MISC + 16)); __syncthreads();
        pg8::EpiSwiGLU E{ACT, args.in[16], (unsigned*)(ctl + CW_MOE), !xcd_known};
#ifdef STAGGER_NS
        { const int cc_ = (G % 8 == 0) ? (cvirt % 8) * (G / 8) + cvirt / 8 : cvirt; const unsigned long long t0_ = rt(), dl_ = (unsigned long long)(cc_ % 8) * (STAGGER_NS / 10); while (rt() - t0_ < dl_) __builtin_amdgcn_s_sleep(1); }
#endif
        pg8::gemm_phase<pg8::EpiSwiGLU, pg8::MoeOrder, true, true, true>(lds, g, S, E);
        if (TS_PHASE == 70) { __syncthreads(); ts_val = *((volatile unsigned long long*)(ws + WS_CTL + 200 * 1024) + blockIdx.x); }
    } STAMP(); }
    if (IN(8)) { for (int rep_ = 0; rep_ < NREP(8); ++rep_) {
        pg8::Gemm g{(const bf16*)ACT, (const bf16*)WD, DE / 2, nullptr, (const unsigned*)(ctl + CW_MOE), 64u}; pg8::MoeOrder S; S.init(TILEPREF, 4, G, cvirt, 1, (volatile LAS int*)(MISC + 16)); __syncthreads();
        pg8::EpiDown E{Y, args.in[18], GATEPOS};
        pg8::gemm_phase<pg8::EpiDown, pg8::MoeOrder, true, false, true, true>(lds, g, S, E);
        if (TS_PHASE == 208 && tid0 == 0) { ((volatile unsigned long long*)(ws + WS_CTL + 328 * 1024))[blockIdx.x] = rt(); __threadfence(); }
        if (BOTH(8)) GRID_BAR();
        if (TS_PHASE == 208 && blockIdx.x == 0 && tid0 == 0) { unsigned long long mx = 0ull, mn = ~0ull; for (int b_ = 0; b_ < G; ++b_) { const unsigned long long v_ = __hip_atomic_load((unsigned long long*)(ws + WS_CTL + 328 * 1024) + b_, __ATOMIC_RELAXED, __HIP_MEMORY_SCOPE_AGENT); mx = v_ > mx ? v_ : mx; mn = v_ < mn ? v_ : mn; } *(volatile unsigned long long*)(ws + WS_CTL + 320 * 1024) = mx - mn; }
    } STAMP(); }
    if (IN(9)) { PHASE_TID(); p9_combine(args.out, X1B, Y, POSSLOT, vcu, G, lane, wave); }
    if (TS_PHASE == 80) {
        GRID_BAR();
        if (blockIdx.x == 0 && wave == 0) {
            typedef int i32x8_ __attribute__((ext_vector_type(8))); typedef short bf16x8_ __attribute__((ext_vector_type(8)));
            f32x4 c0 = {0, 0, 0, 0}, c1 = c0, c2 = c0, c3 = c0; i32x8_ a8; bf16x8_ a4; int sw = 0x7F7F7F7F;
            for (int i = 0; i < 8; ++i) { a8[i] = 0x38383838; a4[i] = 0x3f80; } asm volatile("" : "+v"(a8), "+v"(a4), "+v"(sw));
            const unsigned long long t0 = __builtin_amdgcn_s_memtime();
            for (int i = 0; i < 256; ++i) {
                asm volatile("v_mfma_f32_16x16x32_bf16 %0, %4, %4, %0\n\tv_mfma_f32_16x16x32_bf16 %1, %4, %4, %1\n\tv_mfma_f32_16x16x32_bf16 %2, %4, %4, %2\n\tv_mfma_f32_16x16x32_bf16 %3, %4, %4, %3" : "+v"(c0), "+v"(c1), "+v"(c2), "+v"(c3) : "v"(a4)); }
            asm volatile("s_nop 15\n\ts_nop 15" ::: "memory");
            const unsigned long long t1 = __builtin_amdgcn_s_memtime();
            for (int i = 0; i < 256; ++i) {
                asm volatile("v_mfma_scale_f32_16x16x128_f8f6f4 %0, %4, %4, %0, %5, %5 op_sel_hi:[0,0,0]\n\tv_mfma_scale_f32_16x16x128_f8f6f4 %1, %4, %4, %1, %5, %5 op_sel_hi:[0,0,0]\n\tv_mfma_scale_f32_16x16x128_f8f6f4 %2, %4, %4, %2, %5, %5 op_sel_hi:[0,0,0]\n\tv_mfma_scale_f32_16x16x128_f8f6f4 %3, %4, %4, %3, %5, %5 op_sel_hi:[0,0,0]" : "+v"(c0), "+v"(c1), "+v"(c2), "+v"(c3) : "v"(a8), "v"(sw)); }
            asm volatile("s_nop 15\n\ts_nop 15" ::: "memory");
            const unsigned long long t2 = __builtin_amdgcn_s_memtime();
            asm volatile("" :: "v"(c0), "v"(c1), "v"(c2), "v"(c3));
            if (tid0 == 0) args.out[0] += 10.0f * (float)(t2 - t1) / (float)(t1 - t0);
        }
    }
    if (TS_PHASE >= 0 && TS_PHASE != 80) { GRID_BAR(); STAMP(); if ((TS_PHASE >= 100 && TS_PHASE <= 107) || (TS_PHASE >= 150 && TS_PHASE <= 232)) ts_val = *(volatile unsigned long long*)(ws + WS_CTL + 320 * 1024); if (blockIdx.x == 0 && tid0 == 0) args.out[0] += (CLK_PHASE >= 0) ? clk_val : (float)ts_val * 0.01f * TS_SCALE; }
#undef IN
#undef BOTH
#undef GRID_BAR
}

extern "C" void kernel_launch(void* const* d_in, const int* in_sizes, int n_in, void* d_out, int out_size, void* d_ws, size_t ws_size, hipStream_t stream) {
    static int grid = 0;
    if (grid == 0) {
        if (n_in != 19 || in_sizes[0] != MTOK * DMODEL || out_size != MTOK * DMODEL || ws_size < WS_END) { fprintf(stderr, "kernel_launch: unexpected shapes (n_in %d, in0 %d, out %d, ws %zu); nothing launched\n", n_in, n_in > 0 ? in_sizes[0] : -1, out_size, ws_size); grid = -1; return; }
        int dev = 0, cus = 0, per_cu = 0;
        if (hipGetDevice(&dev) != hipSuccess || hipDeviceGetAttribute(&cus, hipDeviceAttributeMultiprocessorCount, dev) != hipSuccess) { grid = -1; return; }
        if (hipFuncSetAttribute((const void*)hymba_fwd, hipFuncAttributeMaxDynamicSharedMemorySize, LDS_BYTES) != hipSuccess) { fprintf(stderr, "kernel_launch: hipFuncSetAttribute failed\n"); grid = -1; return; }
        if (hipOccupancyMaxActiveBlocksPerMultiprocessor(&per_cu, (const void*)hymba_fwd, NWAVES * 64, LDS_BYTES) != hipSuccess || per_cu < 1) { fprintf(stderr, "kernel_launch: occupancy query reports %d workgroups per CU; nothing launched\n", per_cu); (void)hipGetLastError(); grid = -1; return; }
        (void)hipGetLastError();
        grid = cus;
    }
    if (grid < 0) return;
    if (hipMemsetAsync((char*)d_ws + WS_CTL, 0, CTL_ZERO_BYTES, stream) != hipSuccess) return;
    Args a{};
    for (int i = 0; i < 19; ++i) a.in[i] = (const float*)d_in[i];
    a.out = (float*)d_out; a.ws = (unsigned char*)d_ws;
    for (int li = 0; li < N_LAUNCHES; ++li) {
        a.ph_lo = (N_LAUNCHES == 1) ? 0 : li; a.ph_hi = (N_LAUNCHES == 1) ? N_PHASES : li + 1; a.li = li;
        hipLaunchKernelGGL(hymba_fwd, dim3(grid), dim3(NWAVES * 64), LDS_BYTES, stream, a);
        const hipError_t le = hipPeekAtLastError();
        if (le != hipSuccess) { fprintf(stderr, "kernel_launch: launch %d failed: %s\n", li, hipGetErrorName(le)); break; }
    }
}
```
